# Optimizing an MI355X kernel written in HIP

```python
import math
import jax, jax.numpy as jnp
from jax import lax
import numpy as np

D_MODEL = 1024
BATCH = 4
SEQ = 4096
DEPTH = 1

N_META = 16
D_MIX = D_MODEL
D_CONV = D_MIX // 2
D_SSM = D_MIX - D_CONV
CONV_WIDTH = 31
SSM_GROUP = 16
N_SSM_GROUPS = D_SSM // SSM_GROUP
SSM_STATE = 64
N_DIR = 2
D_FF = 4 * D_MODEL
D_IN_PROJ = 2 * D_CONV + D_SSM
DT_MIN = 1e-3
DT_MAX = 1e-1
NORM_EPS = 1e-5

kernel_name = 'hymba_conformer_s5_bidir_block'


def _rms_norm(x, g):
    xf = x.astype(jnp.float32)
    y = xf * lax.rsqrt(jnp.mean(jnp.square(xf), axis=-1, keepdims=True) + NORM_EPS)
    return (y * g.astype(jnp.float32)).astype(x.dtype)


def _layer_norm(x, g, b):
    xf = x.astype(jnp.float32)
    xc = xf - jnp.mean(xf, axis=-1, keepdims=True)
    y = xc * lax.rsqrt(jnp.mean(jnp.square(xc), axis=-1, keepdims=True) + NORM_EPS)
    return (y * g.astype(jnp.float32) + b.astype(jnp.float32)).astype(x.dtype)


def _conv_module(v, gate, conv_w, conv_b, ln_g, ln_b):
    u = v * jax.nn.sigmoid(gate)
    pad = CONV_WIDTH // 2
    y = lax.conv_general_dilated(
        u, conv_w[:, None, :].astype(u.dtype), window_strides=(1,),
        padding=[(pad, pad)], dimension_numbers=('NWC', 'WIO', 'NWC'),
        feature_group_count=D_CONV)
    y = y + conv_b.astype(u.dtype)
    return jax.nn.silu(_layer_norm(y, ln_g, ln_b))


def _linear_recurrence_op(left, right):
    a_l, b_l = left
    a_r, b_r = right
    return a_r * a_l, a_r * b_l + b_r


def _s5_direction(u, lam_re, lam_im, log_dt, b_re, b_im, c_re, c_im, reverse):
    f32 = jnp.float32
    lam = lax.complex(lam_re.astype(f32), lam_im.astype(f32))
    dt = jnp.exp(log_dt.astype(f32))[:, None]
    lam_bar = jnp.exp(lam * dt)
    b_mat = lax.complex(b_re.astype(f32), b_im.astype(f32))
    b_bar = ((lam_bar - 1.0) / lam)[..., None] * b_mat
    c_mat = lax.complex(c_re.astype(f32), c_im.astype(f32))
    bu = jnp.einsum('gph,blgh->blgp', b_bar, u.astype(jnp.complex64))
    a = jnp.broadcast_to(lam_bar, bu.shape)
    _, states = lax.associative_scan(_linear_recurrence_op, (a, bu), reverse=reverse, axis=1)
    return jnp.einsum('ghp,blgp->blgh', c_mat, states).real


def _s5_mixer(u, lam_re, lam_im, log_dt, b_re, b_im, c_re, c_im, d_skip, glu_w, glu_b):
    bsz, length, _ = u.shape
    uf = u.astype(jnp.float32)
    ug = uf.reshape(bsz, length, N_SSM_GROUPS, SSM_GROUP)
    y = _s5_direction(ug, lam_re[0], lam_im[0], log_dt[0], b_re[0], b_im[0], c_re[0], c_im[0], False)
    for d in range(1, N_DIR):
        y = y + _s5_direction(ug, lam_re[d], lam_im[d], log_dt[d], b_re[d], b_im[d],
                              c_re[d], c_im[d], True)
    y = y.reshape(bsz, length, D_SSM) + d_skip.astype(jnp.float32) * uf
    y = jax.nn.gelu(y).astype(u.dtype)
    return y * jax.nn.sigmoid(y @ glu_w + glu_b)


def setup_inputs(seed: int = 0) -> dict:
    key = jax.random.key(seed)
    ks = jax.random.split(key, 24)
    f32 = jnp.float32

    def nrm(k, shape, scale):
        return jax.random.normal(k, shape, f32) * scale

    ssm_shape = (DEPTH, N_DIR, N_SSM_GROUPS, SSM_STATE)
    n_idx = jnp.arange(SSM_STATE, dtype=f32)
    return {
        'x': nrm(ks[0], (BATCH, SEQ, D_MODEL), 1.0),
        'meta_tokens': nrm(ks[1], (N_META, D_MODEL), 1.0),
        'norm_mix_g': 1.0 + nrm(ks[2], (DEPTH, D_MODEL), 0.01),
        'w_in': nrm(ks[3], (DEPTH, D_MODEL, D_IN_PROJ), D_MODEL ** -0.5),
        'conv_w': nrm(ks[4], (DEPTH, CONV_WIDTH, D_CONV), CONV_WIDTH ** -0.5),
        'conv_b': nrm(ks[5], (DEPTH, D_CONV), 0.01),
        'conv_ln_g': 1.0 + nrm(ks[6], (DEPTH, D_CONV), 0.01),
        'conv_ln_b': nrm(ks[7], (DEPTH, D_CONV), 0.01),
        'ssm_lam_re': -0.5 + nrm(ks[8], ssm_shape, 0.01),
        'ssm_lam_im': math.pi * n_idx + nrm(ks[9], ssm_shape, 0.01),
        'ssm_log_dt': jax.random.uniform(ks[10], (DEPTH, N_DIR, N_SSM_GROUPS), f32,
                                         math.log(DT_MIN), math.log(DT_MAX)),
        'ssm_b_re': nrm(ks[11], (DEPTH, N_DIR, N_SSM_GROUPS, SSM_STATE, SSM_GROUP), (2 * SSM_GROUP) ** -0.5),
        'ssm_b_im': nrm(ks[12], (DEPTH, N_DIR, N_SSM_GROUPS, SSM_STATE, SSM_GROUP), (2 * SSM_GROUP) ** -0.5),
        'ssm_c_re': nrm(ks[13], (DEPTH, N_DIR, N_SSM_GROUPS, SSM_GROUP, SSM_STATE), SSM_STATE ** -0.5),
        'ssm_c_im': nrm(ks[14], (DEPTH, N_DIR, N_SSM_GROUPS, SSM_GROUP, SSM_STATE), SSM_STATE ** -0.5),
        'ssm_d': nrm(ks[15], (DEPTH, D_SSM), 1.0),
        'ssm_glu_w': nrm(ks[16], (DEPTH, D_SSM, D_SSM), D_SSM ** -0.5),
        'ssm_glu_b': nrm(ks[17], (DEPTH, D_SSM), 0.01),
        'w_out': nrm(ks[18], (DEPTH, D_MIX, D_MODEL), D_MIX ** -0.5),
        'norm_ffn_g': 1.0 + nrm(ks[19], (DEPTH, D_MODEL), 0.01),
        'w_ff1': nrm(ks[20], (DEPTH, D_MODEL, D_FF), D_MODEL ** -0.5),
        'w_ff2': nrm(ks[21], (DEPTH, D_FF, D_MODEL), D_FF ** -0.5),
        'norm_final_g': 1.0 + nrm(ks[22], (D_MODEL,), 0.01),
    }


def reference(x, meta_tokens, norm_mix_g, w_in, conv_w, conv_b, conv_ln_g, conv_ln_b,
              ssm_lam_re, ssm_lam_im, ssm_log_dt, ssm_b_re, ssm_b_im, ssm_c_re, ssm_c_im,
              ssm_d, ssm_glu_w, ssm_glu_b, w_out, norm_ffn_g, w_ff1, w_ff2, norm_final_g):
    bsz = x.shape[0]
    meta = jnp.broadcast_to(meta_tokens[None].astype(x.dtype), (bsz, N_META, D_MODEL))
    h = jnp.concatenate([meta, x], axis=1)
    for layer in range(DEPTH):
        z = _rms_norm(h, norm_mix_g[layer])
        p = z @ w_in[layer]
        conv_v = p[..., :D_CONV]
        conv_gate = p[..., D_CONV:2 * D_CONV]
        ssm_u = p[..., 2 * D_CONV:]
        conv_out = _conv_module(conv_v, conv_gate, conv_w[layer], conv_b[layer],
                                conv_ln_g[layer], conv_ln_b[layer])
        ssm_out = _s5_mixer(ssm_u, ssm_lam_re[layer], ssm_lam_im[layer], ssm_log_dt[layer],
                            ssm_b_re[layer], ssm_b_im[layer], ssm_c_re[layer], ssm_c_im[layer],
                            ssm_d[layer], ssm_glu_w[layer], ssm_glu_b[layer])
        mixed = jnp.concatenate([conv_out, ssm_out.astype(conv_out.dtype)], axis=-1)
        h = h + mixed @ w_out[layer]
        z = _rms_norm(h, norm_ffn_g[layer])
        h = h + jnp.square(jax.nn.relu(z @ w_ff1[layer])) @ w_ff2[layer]
    h = _rms_norm(h, norm_final_g)
    return h[:, N_META:, :]
```

```cpp
#include <hip/hip_runtime.h>
#include <hip/hip_cooperative_groups.h>
#include <cstdio>
#include <cstdint>
namespace cg = cooperative_groups;

#define LAS __attribute__((address_space(3)))
typedef unsigned short bf16_t;
typedef short bf16x8 __attribute__((ext_vector_type(8)));
typedef float f32x4 __attribute__((ext_vector_type(4)));
typedef float f32x2 __attribute__((ext_vector_type(2)));
typedef unsigned u32x4 __attribute__((ext_vector_type(4)));
typedef unsigned u32x2 __attribute__((ext_vector_type(2)));

#ifndef MK_MULTI
#define MK_MULTI 0
#endif

constexpr int D = 1024, NTOK = 16384, SEQ = 4096, MROWS = 16640  ;
constexpr int DC = 512, DS = 512, NG = 32, TCH = 32, NCH = 128  , KS = 768  ;
constexpr int DFF = 4096;
constexpr float EPS = 1e-5f;
constexpr size_t MiB = 1u << 20;
constexpr size_t WS_W1T = 1 * MiB, WS_W2T = 9 * MiB, WS_WOUTT = 17 * MiB, WS_WINT = 19 * MiB, WS_GLUT = 22 * MiB, WS_PS = 23 * MiB, WS_PS2 = 24 * MiB,
                 WS_SMALL = 25 * MiB, WS_KT = 26 * MiB, WS_H2B = 28 * MiB, WS_HID = 60 * MiB, WS_Z1 = 60 * MiB, WS_UC = 93 * MiB, WS_AS = 110 * MiB,
                 WS_BTS = 134 * MiB, WS_SL = 158 * MiB, WS_WST = 174 * MiB, WS_MIXED = 188 * MiB, WS_YG = 220 * MiB, WS_END = 236 * MiB;
constexpr size_t SM_UMETA = 0  , SM_LBF = 32768  , SM_LAMT = 65536  , SM_BBF = 131072  , SM_RS1 = 524288  ;

constexpr int LDS_BYTES = 147456;

__device__ __forceinline__ unsigned f2bf(float f) { unsigned u = __builtin_bit_cast(unsigned, f); return (u + 0x7fffu + ((u >> 16) & 1u)) >> 16; }
__device__ __forceinline__ unsigned pk2(float lo, float hi) { return f2bf(lo) | (f2bf(hi) << 16); }
__device__ __forceinline__ unsigned cvt_pk_bf16(float lo, float hi) { unsigned r; asm volatile("v_cvt_pk_bf16_f32 %0, %1, %2" : "=v"(r) : "v"(lo), "v"(hi)); return r; }
__device__ __forceinline__ float bflo(unsigned w) { return __builtin_bit_cast(float, w << 16); }
__device__ __forceinline__ float bfhi(unsigned w) { return __builtin_bit_cast(float, w & 0xffff0000u); }
__device__ __forceinline__ float wave_sum(float v) {
#pragma unroll
    for (int o = 1; o < 64; o <<= 1) v += __shfl_xor(v, o);
    return v;
}
__device__ __forceinline__ float sigmoidf_(float x) { return __builtin_amdgcn_rcpf(1.0f + __expf(-x)); }
__device__ __forceinline__ float gelu_tanh(float x) { const float u = 1.5957691216f * (x + 0.044715f * x * x * x); return x * sigmoidf_(u); }

__device__ __forceinline__ void sincos_d(double a, double& s, double& c) {
    const double k = rint(a * 0.15915494309189535); double r = fma(-k, 6.283185307179586, a); r = fma(-k, 2.4492935982947064e-16, r);
    const double q = r * 0.25, q2 = q * q;
    double sq = q * (1.0 + q2 * (-1.0 / 6 + q2 * (1.0 / 120 + q2 * (-1.0 / 5040 + q2 * (1.0 / 362880 + q2 * (-1.0 / 39916800 + q2 * (1.0 / 6227020800.0)))))));
    double cq = 1.0 + q2 * (-0.5 + q2 * (1.0 / 24 + q2 * (-1.0 / 720 + q2 * (1.0 / 40320 + q2 * (-1.0 / 3628800 + q2 * (1.0 / 479001600.0 + q2 * (-1.0 / 87178291200.0)))))));
    const double s2 = 2.0 * sq * cq, c2 = 1.0 - 2.0 * sq * sq;
    s = 2.0 * s2 * c2; c = 1.0 - 2.0 * s2 * s2;
}

namespace pg8 {
constexpr int BM = 256, BK = 64, HALF = 128, HTB = HALF * BK * 2, STAGE_BYTES = 8 * HTB, NXCD = 8, WGM = 8;
__device__ __forceinline__ int lds_byte(int r, int c) { const int st = (r >> 4) * 2 + (c >> 5), rr = r & 15, cc = c & 31, ob = rr * 64 + cc * 2; return st * 1024 + (ob ^ (((ob >> 9) & 1) << 5)); }
__device__ __forceinline__ void stage_rc(int b, int& R, int& C) { const int st = b / 1024, sb = b % 1024, swz = sb ^ (((sb >> 9) & 1) << 5); R = (st >> 1) * 16 + swz / 64; C = (st & 1) * 32 + (swz % 64) / 2; }
__device__ __forceinline__ int perm32(int rho) { const int n = rho >> 4, i = rho & 15; return 8 * (i >> 2) + 4 * n + (i & 3); }

struct Unit { int pm, pn, g; };
struct Gemm { const bf16_t* A; const bf16_t* Bt; int lda, ldb, K; size_t gsA, gsB; };

struct Order {
    static constexpr bool HASWAIT = false;
    __device__ __forceinline__ void kwait(int) const {}
    int nM, nN, nG, nwg, G, c, rep;
    __device__ void init(int nM_, int nN_, int nG_, int G_, int c_, int rep_ = 1) { nM = nM_; nN = nN_; nG = nG_; nwg = nM * nN * nG; G = G_; c = c_; rep = rep_; }
    __device__ bool next(int i, Unit& u) const {
        long L = (long)i * G + c; if (L >= (long)nwg * rep) return false; L %= nwg;
        if (nG == 1) {
            int wgid = (int)L; { const int q = nwg / NXCD, r = nwg % NXCD, xcd = wgid % NXCD, off = wgid / NXCD; wgid = (xcd < r ? xcd * (q + 1) : r * (q + 1) + (xcd - r) * q) + off; }
            const int nig = WGM * nN, gid = wgid / nig, fm = gid * WGM, gsz = (nM - fm) < WGM ? (nM - fm) : WGM;
            u.pm = fm + ((wgid % nig) % gsz); u.pn = (wgid % nig) / gsz; u.g = 0;
        } else {
            const int per = nM * nN, l = (int)L; u.g = l / per; const int r = l % per; u.pm = r % nM; u.pn = r / nM;
        }
        return true;
    }
};

struct OneUnit {
    static constexpr bool HASWAIT = true;
    Unit u; const unsigned* flag; int wait_t; bool samexcc;
    __device__ __forceinline__ bool next(int i, Unit& o) const { if (i > 0) return false; o = u; return true; }
    __device__ __forceinline__ void kwait(int t) const {
        if (flag == nullptr || t != wait_t) return;
        unsigned spins = 0;
        while ((unsigned)__builtin_amdgcn_readfirstlane(__hip_atomic_load(flag, __ATOMIC_RELAXED, __HIP_MEMORY_SCOPE_AGENT)) == 0u) { __builtin_amdgcn_s_sleep(2); if (++spins > (1u << 22)) break; }
        if (!samexcc) { __builtin_amdgcn_fence(__ATOMIC_ACQUIRE, "agent"); asm volatile("s_waitcnt vmcnt(0)" ::: "memory"); }
        else asm volatile("" ::: "memory");
    }
};

template <class Epi, class Sched = Order, bool ALIGN_EPI = true>
__device__ __forceinline__ void gemm_phase(LAS unsigned char* lds, const Gemm g, const Sched& S, const Epi& E) {
    const int tid = threadIdx.x, wid = __builtin_amdgcn_readfirstlane(tid >> 6), lane = tid & 63, wr = wid >> 2, wc = wid & 3, fr = lane & 15, fq = lane >> 4;
    const int K = g.K, nt = K / BK;
    unsigned voffA[2], voffB[2];
#pragma unroll
    for (int i = 0; i < 2; ++i) { int R, C; stage_rc(tid * 16 + i * 8192, R, C); const int Rb = Epi::PERM ? ((R & ~31) + perm32(R & 31)) : R;
        voffA[i] = (unsigned)(R * g.lda + C) * 2u; voffB[i] = (unsigned)(Rb * g.ldb + C) * 2u; }
    const size_t kstep = (size_t)(BK * 2);
    const size_t hstepA = (size_t)HALF * g.lda * 2, hstepB = (size_t)HALF * g.ldb * 2;
    const unsigned ldsw = (unsigned)wid * 1024u;
    const int aoff = lds_byte(wr * 64 + fr, fq * 8), boff = lds_byte(wc * 32 + fr, fq * 8);
#define PG8_SA(b, h) (((b) * 2 + (h)) * HTB)
#define PG8_SB(b, h) ((4 + (b) * 2 + (h)) * HTB)
#define PG8_STAGE(bufoff, gbase, voff) do { _Pragma("unroll") for (int _i = 0; _i < 2; ++_i) \
        __builtin_amdgcn_global_load_lds((const unsigned*)((const char*)(gbase) + (voff)[_i]), (LAS unsigned*)(lds + (bufoff) + ldsw + _i * 8192), 16, 0, 0); } while (0)
#define PG8_LDA(dst, b, h) do { _Pragma("unroll") for (int m = 0; m < 4; ++m) _Pragma("unroll") for (int k = 0; k < 2; ++k) dst[m][k] = *(const LAS bf16x8*)(lds + PG8_SA(b, h) + aoff + m * 2048 + k * 1024); } while (0)
#define PG8_LDB(dst, b, h) do { _Pragma("unroll") for (int n = 0; n < 2; ++n) _Pragma("unroll") for (int k = 0; k < 2; ++k) dst[n][k] = *(const LAS bf16x8*)(lds + PG8_SB(b, h) + boff + n * 2048 + k * 1024); } while (0)
#define PG8_MMA(ai, bj, At, Bt) do { __builtin_amdgcn_s_setprio(1); _Pragma("unroll") for (int m = 0; m < 4; ++m) _Pragma("unroll") for (int n = 0; n < 2; ++n) _Pragma("unroll") for (int k = 0; k < 2; ++k) \
        acc[ai][bj][m][n] = __builtin_amdgcn_mfma_f32_16x16x32_bf16(Bt[n][k], At[m][k], acc[ai][bj][m][n], 0, 0, 0); __builtin_amdgcn_s_setprio(0); } while (0)
#define PG8_WAIT_V(n) asm volatile("s_waitcnt vmcnt(" #n ")" ::: "memory")
#define PG8_WAIT_L(n) asm volatile("s_waitcnt lgkmcnt(" #n ")" ::: "memory")
#define PG8_BAR __builtin_amdgcn_s_barrier()
#define PG8_SCHED __builtin_amdgcn_sched_barrier(0)
    Unit cur, nxt; int ui = 0;
    if (!S.next(0, cur)) return;
    f32x4 acc[2][2][4][2];
#pragma unroll
    for (int a = 0; a < 2; ++a)
#pragma unroll
        for (int b = 0; b < 2; ++b)
#pragma unroll
            for (int m = 0; m < 4; ++m)
#pragma unroll
                for (int n = 0; n < 2; ++n) acc[a][b][m][n] = (f32x4){0.f, 0.f, 0.f, 0.f};
    bf16x8 At[4][2], B0[2][2], B1[2][2];
    const char* cA = (const char*)(g.A + (size_t)cur.g * g.gsA + (size_t)cur.pm * BM * g.lda);
    const char* cB = (const char*)(g.Bt + (size_t)cur.g * g.gsB + (size_t)cur.pn * BM * g.ldb);
    PG8_STAGE(PG8_SB(0, 0), cB, voffB); PG8_STAGE(PG8_SB(0, 1), cB + hstepB, voffB); PG8_STAGE(PG8_SA(0, 0), cA, voffA); PG8_STAGE(PG8_SA(0, 1), cA + hstepA, voffA);
    if (wr == 1) PG8_BAR;
    PG8_WAIT_V(2); PG8_BAR;
    PG8_STAGE(PG8_SB(1, 0), cB + kstep, voffB); PG8_STAGE(PG8_SA(1, 0), cA + kstep, voffA); PG8_STAGE(PG8_SB(1, 1), cB + hstepB + kstep, voffB);
    PG8_WAIT_V(6); PG8_BAR;
    for (;;) {
        const bool has_next = S.next(ui + 1, nxt);
        const char* nA = has_next ? (const char*)(g.A + (size_t)nxt.g * g.gsA + (size_t)nxt.pm * BM * g.lda) : cA;
        const char* nB = has_next ? (const char*)(g.Bt + (size_t)nxt.g * g.gsB + (size_t)nxt.pn * BM * g.ldb) : cB;
        for (int t = 0; t < nt; t += 2) {
            if constexpr (Sched::HASWAIT) S.kwait(t);
            const bool last = (t == nt - 2);
            const char* a1 = cA + (size_t)(t + 1) * kstep;
            const char* a2 = last ? nA : cA + (size_t)(t + 2) * kstep; const char* b2 = last ? nB : cB + (size_t)(t + 2) * kstep;
            const char* a3 = a2 + kstep; const char* b3 = b2 + kstep;
            PG8_LDB(B0, 0, 0); PG8_LDB(B1, 0, 1); PG8_SCHED; PG8_LDA(At, 0, 0); PG8_STAGE(PG8_SA(1, 1), a1 + hstepA, voffA);
            PG8_WAIT_V(8); PG8_WAIT_L(0); PG8_BAR; PG8_MMA(0, 0, At, B0); PG8_MMA(0, 1, At, B1); PG8_BAR; PG8_SCHED;
            PG8_LDA(At, 0, 1); PG8_STAGE(PG8_SB(0, 0), b2, voffB); PG8_STAGE(PG8_SB(0, 1), b2 + hstepB, voffB); PG8_STAGE(PG8_SA(0, 0), a2, voffA);
            PG8_WAIT_V(8); PG8_WAIT_L(0); PG8_BAR; PG8_MMA(1, 0, At, B0); PG8_MMA(1, 1, At, B1); PG8_BAR; PG8_SCHED;
            PG8_LDB(B0, 1, 0); PG8_LDB(B1, 1, 1); PG8_SCHED; PG8_LDA(At, 1, 0); PG8_STAGE(PG8_SA(0, 1), a2 + hstepA, voffA);
            PG8_WAIT_V(8); PG8_WAIT_L(0); PG8_BAR; PG8_MMA(0, 0, At, B0); PG8_MMA(0, 1, At, B1); PG8_BAR; PG8_SCHED;
            PG8_LDA(At, 1, 1); PG8_STAGE(PG8_SB(1, 0), b3, voffB); PG8_STAGE(PG8_SB(1, 1), b3 + hstepB, voffB); PG8_STAGE(PG8_SA(1, 0), a3, voffA);
            PG8_WAIT_V(8); PG8_WAIT_L(0); PG8_BAR; PG8_MMA(1, 0, At, B0); PG8_MMA(1, 1, At, B1); PG8_BAR; PG8_SCHED;
        }
        if constexpr (ALIGN_EPI) { if (wr == 0) PG8_BAR; }
        E(acc, cur, wr, wc, fr, fq);
        if (!has_next) break;
#pragma unroll
        for (int a = 0; a < 2; ++a)
#pragma unroll
            for (int b = 0; b < 2; ++b)
#pragma unroll
                for (int m = 0; m < 4; ++m)
#pragma unroll
                    for (int n = 0; n < 2; ++n) acc[a][b][m][n] = (f32x4){0.f, 0.f, 0.f, 0.f};
        cur = nxt; cA = nA; cB = nB; ++ui;
        if constexpr (ALIGN_EPI) { if (wr == 1) PG8_BAR; }
    }
    PG8_WAIT_V(0);
    if constexpr (!ALIGN_EPI) { if (wr == 0) PG8_BAR; }
    PG8_BAR;
#undef PG8_SA
#undef PG8_SB
#undef PG8_STAGE
#undef PG8_LDA
#undef PG8_LDB
#undef PG8_MMA
#undef PG8_WAIT_V
#undef PG8_WAIT_L
#undef PG8_BAR
#undef PG8_SCHED
}

typedef f32x4 Acc[2][2][4][2];

struct EpiIn {
    static constexpr bool PERM = true;
    bf16_t* UC; bf16_t* AS; bf16_t* UMETA; const float* RS1;
    __device__ __forceinline__ void operator()(const Acc& acc, const Unit& u, int wr, int wc, int fr, int fq) const {
        const int row0 = u.pm * BM + wr * 64 + fr;
        float rsv[2][4];
#pragma unroll
        for (int ai = 0; ai < 2; ++ai)
#pragma unroll
            for (int m = 0; m < 4; ++m) rsv[ai][m] = RS1[row0 + ai * HALF + m * 16];
        if (u.pn < 4) {
            const int ch0 = u.pn * 128 + wc * 32 + 8 * fq;
#pragma unroll
            for (int ai = 0; ai < 2; ++ai)
#pragma unroll
                for (int m = 0; m < 4; ++m) {
                    const int row = row0 + ai * HALF + m * 16;
                    const float rs = rsv[ai][m];
                    const f32x4 v0 = acc[ai][0][m][0] * rs, v1 = acc[ai][0][m][1] * rs, g0 = acc[ai][1][m][0] * rs, g1 = acc[ai][1][m][1] * rs;
                    u32x4 w;
                    w.x = cvt_pk_bf16(v0[0] * sigmoidf_(g0[0]), v0[1] * sigmoidf_(g0[1])); w.y = cvt_pk_bf16(v0[2] * sigmoidf_(g0[2]), v0[3] * sigmoidf_(g0[3]));
                    w.z = cvt_pk_bf16(v1[0] * sigmoidf_(g1[0]), v1[1] * sigmoidf_(g1[1])); w.w = cvt_pk_bf16(v1[2] * sigmoidf_(g1[2]), v1[3] * sigmoidf_(g1[3]));
                    *(u32x4*)(UC + (size_t)row * DC + ch0) = w;
                }
        } else {
#pragma unroll
            for (int bj = 0; bj < 2; ++bj) {
                const int c0 = (u.pn - 4) * 256 + bj * HALF + wc * 32 + 8 * fq, gg = c0 >> 4, hi0 = c0 & 15;
#pragma unroll
                for (int ai = 0; ai < 2; ++ai)
#pragma unroll
                    for (int m = 0; m < 4; ++m) {
                        const int row = row0 + ai * HALF + m * 16;
                        const float rs = rsv[ai][m];
                        const f32x4 v0 = acc[ai][bj][m][0] * rs, v1 = acc[ai][bj][m][1] * rs;
                        u32x4 w; w.x = cvt_pk_bf16(v0[0], v0[1]); w.y = cvt_pk_bf16(v0[2], v0[3]); w.z = cvt_pk_bf16(v1[0], v1[1]); w.w = cvt_pk_bf16(v1[2], v1[3]);
                        if (row < NTOK) { const int b = row >> 12, pos = row & 4095, ch = pos >> 5, s = pos & 31;
                            *(u32x4*)(AS + ((size_t)gg * 512 + b * NCH + ch) * KS + s * 16 + hi0) = w; }
                        else if (row < NTOK + 16) *(u32x4*)(UMETA + (size_t)(row - NTOK) * DS + c0) = w;
                    }
            }
        }
    }
};
struct EpiSL {
    static constexpr bool PERM = false;
    float* SL;
    __device__ __forceinline__ void operator()(const Acc& acc, const Unit& u, int wr, int wc, int fr, int fq) const {
        const int row0 = u.pm * BM + wr * 64 + fr, col0 = wc * 32 + 4 * fq;
#pragma unroll
        for (int ai = 0; ai < 2; ++ai)
#pragma unroll
            for (int m = 0; m < 4; ++m) { float* rowp = SL + ((size_t)u.g * 512 + row0 + ai * HALF + m * 16) * 256 + col0;
#pragma unroll
                for (int bj = 0; bj < 2; ++bj)
#pragma unroll
                    for (int n = 0; n < 2; ++n) *(f32x4*)(rowp + bj * HALF + n * 16) = acc[ai][bj][m][n]; }
    }
};
struct EpiSsm {
    static constexpr bool PERM = true;
    const bf16_t* AS; const float* Dsk; bf16_t* YG;
    __device__ __forceinline__ void operator()(const Acc& acc, const Unit& u, int wr, int wc, int fr, int fq) const {
        const int row0 = u.pm * BM + wr * 64 + fr, ho0 = (8 * fq) & 15;
        const f32x4 d0 = *(const f32x4*)(Dsk + u.g * 16 + ho0), d1 = *(const f32x4*)(Dsk + u.g * 16 + ho0 + 4);
#pragma unroll
        for (int ai = 0; ai < 2; ++ai) {
            u32x4 uv[1 + 0 * 2][4][2];
#pragma unroll
            for (int m = 0; m < 4; ++m)
#pragma unroll
                for (int bj = 0; bj < 2; ++bj) uv[0][m][bj] = *(const u32x4*)(AS + ((size_t)u.g * 512 + row0 + ai * HALF + m * 16) * KS + u.pn * BM + bj * HALF + wc * 32 + 8 * fq);
#pragma unroll
            for (int m = 0; m < 4; ++m) {
                const int r = row0 + ai * HALF + m * 16;
                const size_t tok0 = (size_t)(r >> 7) * SEQ + (size_t)(r & 127) * TCH;
#pragma unroll
                for (int bj = 0; bj < 2; ++bj) {
                    const int c = u.pn * BM + bj * HALF + wc * 32 + 8 * fq, t = c >> 4;
                    const u32x4 uu = uv[0][m][bj];
                    const f32x4 a0 = acc[ai][bj][m][0], a1 = acc[ai][bj][m][1];
                    float y[8];
                    y[0] = a0[0] + d0[0] * bflo(uu.x); y[1] = a0[1] + d0[1] * bfhi(uu.x); y[2] = a0[2] + d0[2] * bflo(uu.y); y[3] = a0[3] + d0[3] * bfhi(uu.y);
                    y[4] = a1[0] + d1[0] * bflo(uu.z); y[5] = a1[1] + d1[1] * bfhi(uu.z); y[6] = a1[2] + d1[2] * bflo(uu.w); y[7] = a1[3] + d1[3] * bfhi(uu.w);
#pragma unroll
                    for (int j = 0; j < 8; ++j) y[j] = gelu_tanh(y[j]);
                    u32x4 w; w.x = cvt_pk_bf16(y[0], y[1]); w.y = cvt_pk_bf16(y[2], y[3]); w.z = cvt_pk_bf16(y[4], y[5]); w.w = cvt_pk_bf16(y[6], y[7]);
                    *(u32x4*)(YG + (tok0 + t) * DS + u.g * 16 + ho0) = w;
                }
            }
        }
    }
};
struct EpiGlu {
    static constexpr bool PERM = true;
    const bf16_t* YG; const float* bias; bf16_t* MIXED;
    __device__ __forceinline__ void operator()(const Acc& acc, const Unit& u, int wr, int wc, int fr, int fq) const {
        const int row0 = u.pm * BM + wr * 64 + fr;
        f32x4 bv[2][2];
#pragma unroll
        for (int bj = 0; bj < 2; ++bj) { const int c = u.pn * BM + bj * HALF + wc * 32 + 8 * fq; bv[bj][0] = *(const f32x4*)(bias + c); bv[bj][1] = *(const f32x4*)(bias + c + 4); }
#pragma unroll
        for (int ai = 0; ai < 2; ++ai) {
            u32x4 yv[2][4];
#pragma unroll
            for (int bj = 0; bj < 2; ++bj)
#pragma unroll
                for (int m = 0; m < 4; ++m) yv[bj][m] = *(const u32x4*)(YG + (size_t)(row0 + ai * HALF + m * 16) * DS + u.pn * BM + bj * HALF + wc * 32 + 8 * fq);
#pragma unroll
            for (int bj = 0; bj < 2; ++bj) {
                const int c = u.pn * BM + bj * HALF + wc * 32 + 8 * fq;
                const f32x4 b0 = bv[bj][0], b1 = bv[bj][1];
#pragma unroll
                for (int m = 0; m < 4; ++m) {
                    const int row = row0 + ai * HALF + m * 16;
                    const u32x4 yy = yv[bj][m];
                    const f32x4 a0 = acc[ai][bj][m][0] + b0, a1 = acc[ai][bj][m][1] + b1;
                    u32x4 w;
                    w.x = cvt_pk_bf16(bflo(yy.x) * sigmoidf_(a0[0]), bfhi(yy.x) * sigmoidf_(a0[1])); w.y = cvt_pk_bf16(bflo(yy.y) * sigmoidf_(a0[2]), bfhi(yy.y) * sigmoidf_(a0[3]));
                    w.z = cvt_pk_bf16(bflo(yy.z) * sigmoidf_(a1[0]), bfhi(yy.z) * sigmoidf_(a1[1])); w.w = cvt_pk_bf16(bflo(yy.w) * sigmoidf_(a1[2]), bfhi(yy.w) * sigmoidf_(a1[3]));
                    *(u32x4*)(MIXED + (size_t)row * D + DC + c) = w;
                }
            }
        }
    }
};
struct EpiOut {
    static constexpr bool PERM = true;
    const bf16_t* XB; bf16_t* HB; float* PS;
    __device__ __forceinline__ void operator()(const Acc& acc, const Unit& u, int wr, int wc, int fr, int fq) const {
        const int row0 = u.pm * BM + wr * 64 + fr;
#pragma unroll
        for (int ai = 0; ai < 2; ++ai) {
            u32x4 xv[1][4][2];
#pragma unroll
            for (int m = 0; m < 4; ++m)
#pragma unroll
                for (int bj = 0; bj < 2; ++bj) xv[0][m][bj] = *(const u32x4*)(XB + (size_t)(row0 + ai * HALF + m * 16) * D + u.pn * BM + bj * HALF + wc * 32 + 8 * fq);
#pragma unroll
            for (int m = 0; m < 4; ++m) {
                const int row = row0 + ai * HALF + m * 16; float ss = 0.f;
#pragma unroll
                for (int bj = 0; bj < 2; ++bj) {
                    const size_t off = (size_t)row * D + u.pn * BM + bj * HALF + wc * 32 + 8 * fq;
                    const u32x4 xb = xv[0][m][bj];
                    const f32x4 h0 = (f32x4){bflo(xb.x), bfhi(xb.x), bflo(xb.y), bfhi(xb.y)} + acc[ai][bj][m][0], h1 = (f32x4){bflo(xb.z), bfhi(xb.z), bflo(xb.w), bfhi(xb.w)} + acc[ai][bj][m][1];
                    u32x4 w; w.x = cvt_pk_bf16(h0[0], h0[1]); w.y = cvt_pk_bf16(h0[2], h0[3]); w.z = cvt_pk_bf16(h1[0], h1[1]); w.w = cvt_pk_bf16(h1[2], h1[3]); *(u32x4*)(HB + off) = w;
                    ss += (h0[0] * h0[0] + h0[1] * h0[1]) + (h0[2] * h0[2] + h0[3] * h0[3]) + (h1[0] * h1[0] + h1[1] * h1[1]) + (h1[2] * h1[2] + h1[3] * h1[3]);
                }
                ss += __shfl_xor(ss, 16); ss += __shfl_xor(ss, 32);
                if (fq == 0) PS[(size_t)row * 16 + u.pn * 4 + wc] = ss;
            }
        }
    }
};
struct EpiFF1 {
    static constexpr bool PERM = true;
    const float* PS; bf16_t* HID; const unsigned* p6done; unsigned need;
    __device__ __forceinline__ void operator()(const Acc& acc, const Unit& u, int wr, int wc, int fr, int fq) const {
        const int row0 = u.pm * BM + wr * 64 + fr;
        if (u.pn < 4) { unsigned spins = 0; while ((unsigned)__builtin_amdgcn_readfirstlane(__hip_atomic_load(p6done, __ATOMIC_RELAXED, __HIP_MEMORY_SCOPE_AGENT)) < need) { __builtin_amdgcn_s_sleep(2); if (++spins > (1u << 22)) break; } }
#pragma unroll
        for (int ai = 0; ai < 2; ++ai)
#pragma unroll
            for (int m = 0; m < 4; ++m) {
                const int row = row0 + ai * HALF + m * 16;
#pragma unroll
                for (int bj = 0; bj < 2; ++bj) {
                    const size_t off = (size_t)row * DFF + u.pn * BM + bj * HALF + wc * 32 + 8 * fq;
                    float y[8];
#pragma unroll
                    for (int j = 0; j < 4; ++j) { const float a = fmaxf(acc[ai][bj][m][0][j], 0.f), b = fmaxf(acc[ai][bj][m][1][j], 0.f); y[j] = a * a; y[4 + j] = b * b; }
                    u32x4 w; w.x = cvt_pk_bf16(y[0], y[1]); w.y = cvt_pk_bf16(y[2], y[3]); w.z = cvt_pk_bf16(y[4], y[5]); w.w = cvt_pk_bf16(y[6], y[7]);
                    *(u32x4*)(HID + off) = w;
                }
            }
    }
};
struct EpiFinal {
    static constexpr bool PERM = true;
    float* OUT; const bf16_t* HB; float* PS2; unsigned* cnt; const float* gf; const float* PS; bool local;
    __device__ __forceinline__ void operator()(Acc& acc, const Unit& u, int wr, int wc, int fr, int fq) const {
        const int row0 = u.pm * BM + wr * 64 + fr, col0 = u.pn * BM + wc * 32 + 8 * fq;
#pragma unroll
        for (int ai = 0; ai < 2; ++ai) {
            u32x4 hv[4][2]; f32x4 pv[4];
#pragma unroll
            for (int m = 0; m < 4; ++m) { const int row = row0 + ai * HALF + m * 16; pv[m] = *(const f32x4*)(PS + (size_t)row * 16 + fq * 4);
#pragma unroll
                for (int bj = 0; bj < 2; ++bj) hv[m][bj] = *(const u32x4*)(HB + (size_t)row * D + col0 + bj * HALF); }
#pragma unroll
            for (int m = 0; m < 4; ++m) {
                const int row = row0 + ai * HALF + m * 16; float ss = 0.f;
                const f32x4 pq = pv[m];
                float sq = (pq[0] + pq[1]) + (pq[2] + pq[3]); sq += __shfl_xor(sq, 16); sq += __shfl_xor(sq, 32);
                const float rs2 = __builtin_amdgcn_rcpf(sq * (1.0f / D) + EPS);
#pragma unroll
                for (int bj = 0; bj < 2; ++bj) {
                    const size_t off = (size_t)row * D + col0 + bj * HALF;
                    const u32x4 hb = hv[m][bj];
                    const f32x4 h0 = (f32x4){bflo(hb.x), bfhi(hb.x), bflo(hb.y), bfhi(hb.y)} + acc[ai][bj][m][0] * rs2, h1 = (f32x4){bflo(hb.z), bfhi(hb.z), bflo(hb.w), bfhi(hb.w)} + acc[ai][bj][m][1] * rs2;
                    acc[ai][bj][m][0] = h0; acc[ai][bj][m][1] = h1;
                    ss += (h0[0] * h0[0] + h0[1] * h0[1]) + (h0[2] * h0[2] + h0[3] * h0[3]) + (h1[0] * h1[0] + h1[1] * h1[1]) + (h1[2] * h1[2] + h1[3] * h1[3]);
                }
                ss += __shfl_xor(ss, 16); ss += __shfl_xor(ss, 32);
                if (fq == 0) { if (local) PS2[(size_t)row * 16 + u.pn * 4 + wc] = ss; else __hip_atomic_store((unsigned*)(PS2 + (size_t)row * 16 + u.pn * 4 + wc), __builtin_bit_cast(unsigned, ss), __ATOMIC_RELAXED, __HIP_MEMORY_SCOPE_AGENT); }
            }
        }
        asm volatile("s_waitcnt vmcnt(0)" ::: "memory");
        unsigned* c = cnt + 64 * u.pm;
        if (fr == 0 && fq == 0) __hip_atomic_fetch_add(c, 1u, __ATOMIC_RELAXED, __HIP_MEMORY_SCOPE_AGENT);
        { unsigned spins = 0;
          while ((unsigned)__builtin_amdgcn_readfirstlane(__hip_atomic_load(c, __ATOMIC_RELAXED, __HIP_MEMORY_SCOPE_AGENT)) < 32u) { __builtin_amdgcn_s_sleep(2); if (++spins > (1u << 22)) break; } }
        if (!local) __builtin_amdgcn_fence(__ATOMIC_ACQUIRE, "agent");
        else asm volatile("" ::: "memory");
        f32x4 gg[2][2];
#pragma unroll
        for (int bj = 0; bj < 2; ++bj) { gg[bj][0] = *(const f32x4*)(gf + col0 + bj * HALF); gg[bj][1] = *(const f32x4*)(gf + col0 + bj * HALF + 4); }
#pragma unroll
        for (int ai = 0; ai < 2; ++ai) {
            unsigned qv[4][4];
#pragma unroll
            for (int m = 0; m < 4; ++m) { const unsigned* ps = (const unsigned*)(PS2 + (size_t)(row0 + ai * HALF + m * 16) * 16 + fq * 4);
                if (local) { const u32x4 q4 = *(const u32x4*)ps; qv[m][0] = q4.x; qv[m][1] = q4.y; qv[m][2] = q4.z; qv[m][3] = q4.w; }
                else {
#pragma unroll
                    for (int j = 0; j < 4; ++j) qv[m][j] = __hip_atomic_load(ps + j, __ATOMIC_RELAXED, __HIP_MEMORY_SCOPE_AGENT); } }
#pragma unroll
            for (int m = 0; m < 4; ++m) {
                const int row = row0 + ai * HALF + m * 16;
                float ss = 0.f;
#pragma unroll
                for (int j = 0; j < 4; ++j) ss += __builtin_bit_cast(float, qv[m][j]);
                ss += __shfl_xor(ss, 16); ss += __shfl_xor(ss, 32);
                const float rstd = 1.0f / sqrtf(ss * (1.0f / D) + EPS);
#pragma unroll
                for (int bj = 0; bj < 2; ++bj) {
                    const size_t off = (size_t)row * D + col0 + bj * HALF;
                    *(f32x4*)(OUT + off) = acc[ai][bj][m][0] * rstd * gg[bj][0]; *(f32x4*)(OUT + off + 4) = acc[ai][bj][m][1] * rstd * gg[bj][1];
                }
            }
        }
    }
};
}


#define XB_TMO      128
#define XB_XCNT(j)  (256  + 64 * (j))
#define XB_XSUB(j)  (1280 + 64 * (j))
#define XB_XGEN(j)  (2304 + 64 * (j))
#define XB_TOP      3328
#define XB_TOPGEN   3392
#define XCD_BAR_WORDS 3456
#define XB_SPIN_CAP (1u << 18)
__device__ __forceinline__ unsigned xb_ld(unsigned* p)              { return __hip_atomic_load(p, __ATOMIC_RELAXED, __HIP_MEMORY_SCOPE_AGENT); }
__device__ __forceinline__ unsigned xb_add(unsigned* p, unsigned v) { return __hip_atomic_fetch_add(p, v, __ATOMIC_RELAXED, __HIP_MEMORY_SCOPE_AGENT); }
__device__ __forceinline__ unsigned xb_xcc_id() { return (unsigned)__builtin_amdgcn_s_getreg((3 << 11) | 20) & 0xFu; }
#define XB_SPIN(cond, bar) do { unsigned _sp = 0; while (cond) { __builtin_amdgcn_s_sleep(1); \
    if ((++_sp & 255u) == 0u) { if (xb_ld(&(bar)[XB_TMO])) break; if (_sp > XB_SPIN_CAP) { atomicAdd(&(bar)[XB_TMO], 1u); break; } } } } while (0)
struct XcdBarrier { unsigned* bar; unsigned x; volatile LAS unsigned* st; unsigned rank; };
__device__ __forceinline__ XcdBarrier xcd_barrier_post(unsigned* bar, volatile LAS unsigned* st) {
    XcdBarrier b; b.bar = bar; b.x = xb_xcc_id(); b.st = st;
    b.rank = 0u;
    if (threadIdx.x == 0) b.rank = xb_add(&bar[XB_XCNT(b.x)], 1u);
    return b;
}
#define XL_CNT(j)   (3456 + 64 * (j))
__device__ __forceinline__ void xcc_local_barrier(const XcdBarrier& b, unsigned nloc, bool inval) {
    asm volatile("s_waitcnt vmcnt(0)" ::: "memory");
    __syncthreads();
    if (threadIdx.x == 0) {
        unsigned* bar = b.bar;
        __builtin_amdgcn_s_waitcnt(0);
        const unsigned old = xb_add(&bar[XL_CNT(b.x)], 1u), target = (old / nloc + 1u) * nloc;
        XB_SPIN(xb_ld(&bar[XL_CNT(b.x)]) < target, bar);
        if (inval) { __builtin_amdgcn_fence(__ATOMIC_ACQUIRE, "agent"); asm volatile("s_waitcnt vmcnt(0)" ::: "memory"); }
    }
    __syncthreads();
}
__device__ __forceinline__ void xcd_barrier_complete(unsigned* bar, unsigned x, unsigned& nloc, unsigned& nx) {
    const unsigned G = gridDim.x * gridDim.y * gridDim.z;
    unsigned sum, cnt, mine, sp = 0u;
    for (;;) {
        sum = 0u; cnt = 0u; mine = 0u;
#pragma unroll
        for (unsigned j = 0; j < 16; ++j) { const unsigned c = xb_ld(&bar[XB_XCNT(j)]); sum += c; cnt += (c > 0u) ? 1u : 0u; mine = (j == x) ? c : mine; }
        if (sum == G) break;
        __builtin_amdgcn_s_sleep(1);
        if ((++sp & 255u) == 0u) { if (xb_ld(&bar[XB_TMO])) break; if (sp > XB_SPIN_CAP) { atomicAdd(&bar[XB_TMO], 1u); break; } }
    }
    nloc = mine > 0u ? mine : 1u; nx = cnt > 0u ? cnt : 1u;
}
__device__ __forceinline__ void xcd_barrier(const XcdBarrier& b) {
    asm volatile("s_waitcnt vmcnt(0)" ::: "memory");
    __syncthreads();
    if (threadIdx.x == 0) {
        unsigned* bar = b.bar;
        __builtin_amdgcn_s_waitcnt(0);
        unsigned nloc = b.st[0], nx = b.st[1];
        if (nloc == 0u) { xcd_barrier_complete(bar, b.x, nloc, nx); b.st[0] = nloc; b.st[1] = nx; }
        const unsigned old = xb_add(&bar[XB_XSUB(b.x)], 1u);
        const unsigned gen = old / nloc;
        if (old + 1u == (gen + 1u) * nloc) {
            __builtin_amdgcn_fence(__ATOMIC_RELEASE, "agent");
            asm volatile("s_waitcnt vmcnt(0)" ::: "memory");
            const unsigned og = xb_add(&bar[XB_TOP], 1u);
            const unsigned tg = og / nx;
            if (og + 1u == (tg + 1u) * nx) xb_add(&bar[XB_TOPGEN], 1u);
            else XB_SPIN(xb_ld(&bar[XB_TOPGEN]) == tg, bar);
            __builtin_amdgcn_fence(__ATOMIC_ACQUIRE, "agent");
            xb_add(&bar[XB_XGEN(b.x)], 1u);
            asm volatile("s_waitcnt vmcnt(0)" ::: "memory");
        } else {
            XB_SPIN(xb_ld(&bar[XB_XGEN(b.x)]) == gen, bar);
            __builtin_amdgcn_fence(__ATOMIC_ACQUIRE, "agent");
            asm volatile("s_waitcnt vmcnt(0)" ::: "memory");
        }
    }
    __syncthreads();
}

struct Args { const float* in[23]; float* out; unsigned char* ws; int ph_lo, ph_hi; };
enum { I_X = 0, I_META, I_G1, I_WIN, I_CW, I_CB, I_LNG, I_LNB, I_LRE, I_LIM, I_LDT, I_BRE, I_BIM, I_CRE, I_CIM, I_DSK, I_GLUW, I_GLUB, I_WOUT, I_G2, I_W1, I_W2, I_GF };

__device__ __forceinline__ void transpose_item(const float* W, int K, int N, bf16_t* WT, int k0, int srcn0, int dstn0, const float* kscale, LAS float* scr, int lane) {
    f32x4 v[8];
#pragma unroll
    for (int i = 0; i < 8; ++i) { const int kk = 8 * i + (lane >> 3); v[i] = *(const f32x4*)(W + (size_t)(k0 + kk) * N + srcn0 + 4 * (lane & 7)); }
    if (kscale) {
#pragma unroll
        for (int i = 0; i < 8; ++i) v[i] = v[i] * kscale[k0 + 8 * i + (lane >> 3)];
    }
#pragma unroll
    for (int i = 0; i < 8; ++i) { LAS float* d = scr + (8 * i + (lane >> 3)) * 33 + 4 * (lane & 7); d[0] = v[i][0]; d[1] = v[i][1]; d[2] = v[i][2]; d[3] = v[i][3]; }
    asm volatile("s_waitcnt lgkmcnt(0)" ::: "memory");
    const int c = lane & 7;
#pragma unroll
    for (int j = 0; j < 4; ++j) { const int n = (lane >> 3) + 8 * j; const LAS float* s = scr + (8 * c) * 33 + n;
        u32x4 o; o.x = pk2(s[0 * 33], s[1 * 33]); o.y = pk2(s[2 * 33], s[3 * 33]); o.z = pk2(s[4 * 33], s[5 * 33]); o.w = pk2(s[6 * 33], s[7 * 33]);
        *(u32x4*)(WT + (size_t)(dstn0 + n) * K + k0 + 8 * c) = o; }
    asm volatile("s_waitcnt lgkmcnt(0)" ::: "memory");
}

__device__ __forceinline__ void phase_transposes(const Args& a, LAS unsigned char* lds, int lane, int wave, int gw, int NGW, int it0, int it1) {
    unsigned char* ws = a.ws;
    LAS float* scr = (LAS float*)(lds + wave * 16384);
    constexpr int I_IN = 16 * 48, I_GL = 8 * 16, I_OU = 16 * 32, I_1 = 16 * 128;
    for (int it = it0 + gw; it < it1; it += NGW) {
        int r = it;
        if (r < I_IN) { const int kb = r / 48, nb = r % 48, n0 = nb * 32; int src;
            if (n0 < 1024) { const int pn = n0 >> 8, rr = n0 & 255; src = rr < 128 ? pn * 128 + rr : 512 + pn * 128 + (rr - 128); } else src = n0;
            transpose_item(a.in[I_WIN], 1024, 1536, (bf16_t*)(ws + WS_WINT), kb * 64, src, n0, a.in[I_G1], scr, lane); continue; } r -= I_IN;
        if (r < I_GL) { const int kb = r / 16, nb = r % 16; transpose_item(a.in[I_GLUW], 512, 512, (bf16_t*)(ws + WS_GLUT), kb * 64, nb * 32, nb * 32, nullptr, scr, lane); continue; } r -= I_GL;
        if (r < I_OU) { const int kb = r / 32, nb = r % 32; transpose_item(a.in[I_WOUT], 1024, 1024, (bf16_t*)(ws + WS_WOUTT), kb * 64, nb * 32, nb * 32, nullptr, scr, lane); continue; } r -= I_OU;
        if (r < I_1) { const int kb = r / 128, nb = r % 128; transpose_item(a.in[I_W1], 1024, 4096, (bf16_t*)(ws + WS_W1T), kb * 64, nb * 32, nb * 32, a.in[I_G2], scr, lane); continue; } r -= I_1;
        { const int kb = r / 32, nb = r % 32; transpose_item(a.in[I_W2], 4096, 1024, (bf16_t*)(ws + WS_W2T), kb * 64, nb * 32, nb * 32, nullptr, scr, lane); }
    }
}

__device__ __forceinline__ void xb_rows(const Args& a, int lane, int m_begin, int m_end, int gwz, int NGWz) {
    unsigned char* ws = a.ws;
    bf16_t* Z1 = (bf16_t*)(ws + WS_Z1); float* RS1 = (float*)(ws + WS_SMALL + SM_RS1);
    for (int m0 = m_begin + gwz * 4; m0 < m_end; m0 += NGWz * 4) {
        if (m0 >= NTOK + 16) {
#pragma unroll
            for (int r = 0; r < 4; ++r) { u32x2* o8 = (u32x2*)(Z1 + (size_t)(m0 + r) * D) + lane;
#pragma unroll
                for (int j = 0; j < 4; ++j) o8[64 * j] = (u32x2){0u, 0u};
                if (lane == 0) RS1[m0 + r] = 0.f; }
            continue; }
        f32x4 v[4][4];
#pragma unroll
        for (int r = 0; r < 4; ++r) { const int m = m0 + r;
            const f32x4* xr = (const f32x4*)(m < NTOK ? a.in[I_X] + (size_t)m * D : a.in[I_META] + (size_t)(m - NTOK) * D) + lane;
#pragma unroll
            for (int j = 0; j < 4; ++j) v[r][j] = xr[64 * j]; }
#pragma unroll
        for (int r = 0; r < 4; ++r) { const int m = m0 + r; u32x2* o8 = (u32x2*)(Z1 + (size_t)m * D) + lane; float s = 0.f;
#pragma unroll
            for (int j = 0; j < 4; ++j) { s += (v[r][j][0] * v[r][j][0] + v[r][j][1] * v[r][j][1]) + (v[r][j][2] * v[r][j][2] + v[r][j][3] * v[r][j][3]); o8[64 * j] = (u32x2){pk2(v[r][j][0], v[r][j][1]), pk2(v[r][j][2], v[r][j][3])}; }
            const float rstd = 1.0f / sqrtf(wave_sum(s) * (1.0f / D) + EPS);
            if (lane == 0) RS1[m] = rstd; }
    }
}

__device__ __forceinline__ void phase0(const Args& a, LAS unsigned char* lds, int tid, int lane, int wave) {
    unsigned char* ws = a.ws;
    const bool split = gridDim.x >= 256;
    const int gw = split ? ((int)blockIdx.x - 128) * 8 + wave : (int)blockIdx.x * 8 + wave, NGW = split ? ((int)gridDim.x - 128) * 8 : (int)gridDim.x * 8;
#ifndef P0_PARTS
#define P0_PARTS 7
#endif
    for (int item = blockIdx.x; item < ((P0_PARTS & 1) ? 128 : 0); item += gridDim.x) {
        const int g = item >> 2, dir = (item >> 1) & 1, hh = item & 1;
        LAS f32x2* pw = (LAS f32x2*)lds;
        LAS f32x2* Bb = pw + 33 * 64;
        LAS f32x2* Cc = Bb + 64 * 16;
        LAS f32x2* cf = Cc + 16 * 64;
        const float* lre = a.in[I_LRE] + (dir * NG + g) * 64; const float* lim = a.in[I_LIM] + (dir * NG + g) * 64;
        const double dt = exp((double)a.in[I_LDT][dir * NG + g]);
        if (tid < 64) {
            const double lr = lre[tid], li = lim[tid], mg = exp(lr * dt); double sn, cs; sincos_d(li * dt, sn, cs);
            const double br = mg * cs - 1.0, bi = mg * sn, den = lr * lr + li * li;
            cf[tid] = (f32x2){(float)((br * lr + bi * li) / den), (float)((bi * lr - br * li) / den)};
        }
#pragma unroll 1
        for (int idx = tid; idx < 33 * 64; idx += 512) { const int j = idx >> 6, p = idx & 63; const double lr = lre[p], li = lim[p], an = j * li * dt;
            const float mg = expf((float)(j * lr * dt));
            const double k = rint(an * 0.15915494309189535); double r = fma(-k, 6.283185307179586, an); r = fma(-k, 2.4492935982947064e-16, r);
            const float rf = (float)r;
            pw[idx] = (f32x2){mg * cosf(rf), mg * sinf(rf)}; }
        __syncthreads();
        for (int idx = tid; idx < 1024; idx += 512) {
            const int p = idx >> 4; const f32x2 c = cf[p]; const size_t gi = (size_t)(dir * NG + g) * 1024 + idx;
            const float br = a.in[I_BRE][gi], bi = a.in[I_BIM][gi];
            Bb[idx] = (f32x2){c.x * br - c.y * bi, c.x * bi + c.y * br};
            Cc[idx] = (f32x2){a.in[I_CRE][gi], a.in[I_CIM][gi]};
        }
        __syncthreads();
        { float* KT = (float*)(ws + WS_KT); const int e = tid & 255, ho = e >> 4, hi = e & 15, d0 = hh * 16 + (tid >> 8) * 8;
          f32x2 q[64];
#pragma unroll
          for (int p = 0; p < 64; ++p) { const f32x2 c = Cc[ho * 64 + p], b = Bb[p * 16 + hi]; q[p] = (f32x2){c.x * b.x - c.y * b.y, c.x * b.y + c.y * b.x}; }
#pragma unroll 1
          for (int d = d0; d < d0 + 8; ++d) { float s0 = 0.f, s1 = 0.f;
#pragma unroll
              for (int p = 0; p < 64; p += 2) { const f32x4 w = *(const LAS f32x4*)(pw + d * 64 + p); s0 += q[p].x * w[0] - q[p].y * w[1]; s1 += q[p + 1].x * w[2] - q[p + 1].y * w[3]; }
              KT[((size_t)(g * 2 + dir) * 32 + d) * 256 + e] = s0 + s1; } }
        { bf16_t* WST = (bf16_t*)(ws + WS_WST);
#pragma unroll 1
          for (int idx = hh * 64 * 256 + tid; idx < (hh + 1) * 64 * 256; idx += 512) { const int nn = idx >> 8, kp = idx & 255, p = nn >> 1, c = nn & 1, k = 2 * kp, s = k >> 4, hi = k & 15, e = dir == 0 ? 31 - s : s;
              const f32x2 w = pw[e * 64 + p], b0 = Bb[p * 16 + hi], b1 = Bb[p * 16 + hi + 1];
              const float v0 = c ? (w.x * b0.y + w.y * b0.x) : (w.x * b0.x - w.y * b0.y), v1 = c ? (w.x * b1.y + w.y * b1.x) : (w.x * b1.x - w.y * b1.y);
              *(unsigned*)(WST + ((size_t)g * 256 + dir * 128 + nn) * 512 + k) = pk2(v0, v1); } }
        { bf16_t* BTS = (bf16_t*)(ws + WS_BTS);
#pragma unroll 1
          for (int idx = hh * 256 * 64 + tid; idx < (hh + 1) * 256 * 64; idx += 512) { const int n = idx >> 6, p = idx & 63, t = n >> 4, ho = n & 15, e = dir == 0 ? t + 1 : 32 - t;
              const f32x2 c = Cc[ho * 64 + p], w = pw[e * 64 + p];
              *(unsigned*)(BTS + ((size_t)g * 512 + n) * KS + 512 + dir * 128 + 2 * p) = pk2(c.x * w.x - c.y * w.y, -(c.x * w.y + c.y * w.x)); } }
        if (hh == 0 && tid < 64) { ((f32x2*)(ws + WS_SMALL + SM_LAMT))[(g * 2 + dir) * 64 + tid] = pw[32 * 64 + tid];
            if (dir == 0) ((f32x2*)(ws + WS_SMALL + SM_LBF))[g * 64 + tid] = pw[64 + tid]; }
        if (hh == 0 && dir == 0) for (int idx = tid; idx < 1024; idx += 512) ((f32x2*)(ws + WS_SMALL + SM_BBF))[(size_t)g * 1024 + idx] = Bb[idx];
        __syncthreads();
    }
    if ((P0_PARTS & 2) && gw >= 0) phase_transposes(a, lds, lane, wave, gw, NGW, 0, 768);
    if ((P0_PARTS & 4) && gw >= 0) xb_rows(a, lane, 0, split ? NTOK : MROWS, gw, NGW);
    if ((P0_PARTS & 4) && split && (int)blockIdx.x < 128) xb_rows(a, lane, NTOK, MROWS, (int)blockIdx.x * 8 + wave, 128 * 8);
}

__device__ __forceinline__ void phase_conv(const Args& a, LAS unsigned char* lds, int tid, int lane, int wave, int it0, int it1, int stride) {
    const bf16_t* UC = (const bf16_t*)(a.ws + WS_UC); bf16_t* MIXED = (bf16_t*)(a.ws + WS_MIXED);
    LAS unsigned char* ut = lds;
    LAS float* yt = (LAS float*)(lds + 49152);
    const int cp = tid & 255, half = tid >> 8;
    const float* cw = a.in[I_CW];
    f32x2 wk[31];
#pragma unroll
    for (int k = 0; k < 31; ++k) wk[k] = *(const f32x2*)(cw + k * DC + 2 * cp);
    const f32x2 bia = *(const f32x2*)(a.in[I_CB] + 2 * cp);
    const f32x4 lg0 = *(const f32x4*)(a.in[I_LNG] + lane * 8), lg1 = *(const f32x4*)(a.in[I_LNG] + lane * 8 + 4), lb0 = *(const f32x4*)(a.in[I_LNB] + lane * 8), lb1 = *(const f32x4*)(a.in[I_LNB] + lane * 8 + 4);
    u32x4 pf[6];
#define CONV_FETCH(item) do { const int b_ = (item) >> 8, q0_ = ((item) & 255) * 16; _Pragma("unroll") for (int e_ = 0; e_ < 6; ++e_) { const int idx = tid + e_ * 512, r = idx >> 6, cc = idx & 63, q = q0_ - 15 + r; \
        u32x4 v = (u32x4){0u, 0u, 0u, 0u}; \
        if (idx < 46 * 64) { if (q >= 0 && q < SEQ) v = *(const u32x4*)(UC + ((size_t)b_ * SEQ + q) * DC + cc * 8); else if (q < 0) v = *(const u32x4*)(UC + ((size_t)NTOK + 16 + q) * DC + cc * 8); } \
        pf[e_] = v; } } while (0)
    if (it0 < it1) CONV_FETCH(it0);
    for (int it = it0; it < it1; it += stride) {
        const int b = it >> 8, q0 = (it & 255) * 16;
#pragma unroll
        for (int e_ = 0; e_ < 6; ++e_) { const int idx = tid + e_ * 512, r = idx >> 6, cc = idx & 63; if (idx < 46 * 64) *(LAS u32x4*)(ut + r * 1024 + cc * 16) = pf[e_]; }
        __syncthreads();
        if (it + stride < it1) CONV_FETCH(it + stride);
        {
            f32x2 ac[8];
#pragma unroll
            for (int j = 0; j < 8; ++j) ac[j] = bia;
#pragma unroll
            for (int i = 0; i < 38; ++i) {
                const unsigned w = *(const LAS unsigned*)(ut + (half * 8 + i) * 1024 + cp * 4); const f32x2 uu = (f32x2){bflo(w), bfhi(w)};
#pragma unroll
                for (int j = 0; j < 8; ++j) { const int k = i - j; if (k >= 0 && k < 31) ac[j] = __builtin_elementwise_fma(wk[k], uu, ac[j]); }
            }
#pragma unroll
            for (int j = 0; j < 8; ++j) *(LAS f32x2*)(yt + (half * 8 + j) * 512 + 2 * cp) = ac[j];
        }
        __syncthreads();
        {
            const int t0 = wave * 2;
            f32x4 v[2][2]; float s1[2], s2[2];
#pragma unroll
            for (int tt = 0; tt < 2; ++tt) { v[tt][0] = *(const LAS f32x4*)(yt + (t0 + tt) * 512 + lane * 8); v[tt][1] = *(const LAS f32x4*)(yt + (t0 + tt) * 512 + lane * 8 + 4);
                const f32x4 a0 = v[tt][0], a1 = v[tt][1];
                s1[tt] = (a0[0] + a0[1]) + (a0[2] + a0[3]) + (a1[0] + a1[1]) + (a1[2] + a1[3]);
                s2[tt] = (a0[0] * a0[0] + a0[1] * a0[1]) + (a0[2] * a0[2] + a0[3] * a0[3]) + (a1[0] * a1[0] + a1[1] * a1[1]) + (a1[2] * a1[2] + a1[3] * a1[3]); }
#pragma unroll
            for (int o = 1; o < 64; o <<= 1) { const float p0 = __shfl_xor(s1[0], o), p1 = __shfl_xor(s2[0], o), p2 = __shfl_xor(s1[1], o), p3 = __shfl_xor(s2[1], o); s1[0] += p0; s2[0] += p1; s1[1] += p2; s2[1] += p3; }
#pragma unroll
            for (int tt = 0; tt < 2; ++tt) {
                const float mean = s1[tt] * (1.0f / DC), var = fmaxf(s2[tt] * (1.0f / DC) - mean * mean, 0.f), rstd = 1.0f / sqrtf(var + EPS);
                f32x4 y0 = (v[tt][0] - mean) * rstd * lg0 + lb0, y1 = (v[tt][1] - mean) * rstd * lg1 + lb1;
#pragma unroll
                for (int j = 0; j < 4; ++j) { y0[j] = y0[j] * sigmoidf_(y0[j]); y1[j] = y1[j] * sigmoidf_(y1[j]); }
                u32x4 w; w.x = cvt_pk_bf16(y0[0], y0[1]); w.y = cvt_pk_bf16(y0[2], y0[3]); w.z = cvt_pk_bf16(y1[0], y1[1]); w.w = cvt_pk_bf16(y1[2], y1[3]);
                *(u32x4*)(MIXED + ((size_t)b * SEQ + q0 + t0 + tt) * D + lane * 8) = w;
            }
        }
        __syncthreads();
    }
}

__device__ __forceinline__ void phase_toeplitz(const Args& a, int tid, int sidx, int scnt) {
    const float* KT = (const float*)(a.ws + WS_KT); bf16_t* BTS = (bf16_t*)(a.ws + WS_BTS);
    const size_t total = (size_t)NG * 512 * 64;
    for (size_t idx = (size_t)sidx * 512 + tid; idx < total; idx += (size_t)scnt * 512) {
        const int kc = (int)(idx & 63), n = (int)((idx >> 6) & 511), g = (int)(idx >> 15);
        const int t = n >> 4, ho = n & 15, k = kc * 8, s = k >> 4, hi = k & 15, d = t - s;
        f32x4 v0, v1;
        if (d > 0) { const float* p = KT + ((size_t)(g * 2 + 0) * 32 + d) * 256 + ho * 16 + hi; v0 = *(const f32x4*)p; v1 = *(const f32x4*)(p + 4); }
        else if (d < 0) { const float* p = KT + ((size_t)(g * 2 + 1) * 32 - d) * 256 + ho * 16 + hi; v0 = *(const f32x4*)p; v1 = *(const f32x4*)(p + 4); }
        else { const float* p = KT + ((size_t)(g * 2 + 0) * 32) * 256 + ho * 16 + hi; const float* q = KT + ((size_t)(g * 2 + 1) * 32) * 256 + ho * 16 + hi;
            v0 = *(const f32x4*)p + *(const f32x4*)q; v1 = *(const f32x4*)(p + 4) + *(const f32x4*)(q + 4); }
        u32x4 w; w.x = pk2(v0[0], v0[1]); w.y = pk2(v0[2], v0[3]); w.z = pk2(v1[0], v1[1]); w.w = pk2(v1[2], v1[3]);
        *(u32x4*)(BTS + ((size_t)g * 512 + n) * KS + k) = w;
    }
}

template <int DIR>
__device__ __forceinline__ void scan_run(const f32x2* __restrict__ sl, unsigned* __restrict__ dst, const f32x2 lt, float xr, float xi) {
    constexpr int BT = 8, NB = NCH / BT;
    f32x2 s0[BT], s1[BT], s2[BT];
#define SCAN_LD(dstv, bt) do { _Pragma("unroll") for (int j = 0; j < BT; ++j) { const int cc = (bt) * BT + j, c = DIR == 0 ? cc : NCH - 1 - cc; dstv[j] = sl[(size_t)c * 128]; } } while (0)
#define SCAN_RUN(srcv, bt) do { _Pragma("unroll") for (int j = 0; j < BT; ++j) { const int cc = (bt) * BT + j, c = DIR == 0 ? cc : NCH - 1 - cc; \
        dst[(size_t)c * (KS / 2)] = pk2(xr, xi); const float nr = lt[0] * xr - lt[1] * xi + srcv[j][0], ni = lt[0] * xi + lt[1] * xr + srcv[j][1]; xr = nr; xi = ni; } } while (0)
    SCAN_LD(s0, 0); SCAN_LD(s1, 1);
#pragma unroll 1
    for (int bt = 0; bt < NB; bt += 3) {
        if (bt + 2 < NB) SCAN_LD(s2, bt + 2);
        SCAN_RUN(s0, bt);
        if (bt + 1 < NB) { if (bt + 3 < NB) SCAN_LD(s0, bt + 3); SCAN_RUN(s1, bt + 1); }
        if (bt + 2 < NB) { if (bt + 4 < NB) SCAN_LD(s1, bt + 4); SCAN_RUN(s2, bt + 2); }
    }
#undef SCAN_LD
#undef SCAN_RUN
}
__device__ __forceinline__ void scan_one(const Args& a, int b, int g, int dir, int p) {
    unsigned char* ws = a.ws;
    const float* SL = (const float*)(ws + WS_SL); bf16_t* AS = (bf16_t*)(ws + WS_AS);
    const f32x2 lt = ((const f32x2*)(ws + WS_SMALL + SM_LAMT))[(g * 2 + dir) * 64 + p];
    const f32x2* sl = (const f32x2*)(SL + ((size_t)g * 512 + b * NCH) * 256 + dir * 128 + 2 * p);
    unsigned* dst = (unsigned*)(AS + ((size_t)g * 512 + b * NCH) * KS + 512 + dir * 128 + 2 * p);
    if (dir == 0) {
        float xr = 0.f, xi = 0.f;
        const f32x2 lb = ((const f32x2*)(ws + WS_SMALL + SM_LBF))[g * 64 + p];
        const f32x2* bb = (const f32x2*)(ws + WS_SMALL + SM_BBF) + (size_t)(g * 64 + p) * 16;
        const bf16_t* um = (const bf16_t*)(ws + WS_SMALL + SM_UMETA) + g * 16;
        f32x2 bv[16];
#pragma unroll
        for (int h = 0; h < 16; ++h) bv[h] = bb[h];
#pragma unroll 4
        for (int s = 0; s < 16; ++s) { float br = 0.f, bi = 0.f;
            const u32x4 u0 = *(const u32x4*)(um + s * DS), u1 = *(const u32x4*)(um + s * DS + 8);
            const float uv[16] = {bflo(u0.x), bfhi(u0.x), bflo(u0.y), bfhi(u0.y), bflo(u0.z), bfhi(u0.z), bflo(u0.w), bfhi(u0.w), bflo(u1.x), bfhi(u1.x), bflo(u1.y), bfhi(u1.y), bflo(u1.z), bfhi(u1.z), bflo(u1.w), bfhi(u1.w)};
#pragma unroll
            for (int h = 0; h < 16; ++h) { br += bv[h][0] * uv[h]; bi += bv[h][1] * uv[h]; }
            const float nr = lb[0] * xr - lb[1] * xi + br, ni = lb[0] * xi + lb[1] * xr + bi; xr = nr; xi = ni; }
        scan_run<0>(sl, dst, lt, xr, xi);
    } else scan_run<1>(sl, dst, lt, 0.f, 0.f);
}

__device__ __forceinline__ void phase_final(const Args& a, int lane, int wave) {
    const float* PS2 = (const float*)(a.ws + WS_PS2);
    f32x4 gv[4];
#pragma unroll
    for (int j = 0; j < 4; ++j) gv[j] = ((const f32x4*)a.in[I_GF])[lane + 64 * j];
    for (int m = blockIdx.x * 8 + wave; m < NTOK; m += gridDim.x * 8) {
        float ss = PS2[(size_t)m * 16 + (lane & 15)];
        ss += __shfl_xor(ss, 1); ss += __shfl_xor(ss, 2); ss += __shfl_xor(ss, 4); ss += __shfl_xor(ss, 8);
        const float rstd = 1.0f / sqrtf(ss * (1.0f / D) + EPS);
        f32x4* row = (f32x4*)(a.out + (size_t)m * D) + lane;
#pragma unroll
        for (int j = 0; j < 4; ++j) { const f32x4 v = row[64 * j]; row[64 * j] = v * rstd * gv[j]; }
    }
}

constexpr int NPHASE = 10;
template <bool COOP>
__global__ void __launch_bounds__(512, 2) fwd_kernel(Args a) {
    extern __shared__ __attribute__((aligned(16))) unsigned char lds_raw[];
    LAS unsigned char* lds = (LAS unsigned char*)lds_raw;
    const int tid = threadIdx.x, lane = tid & 63, wave = __builtin_amdgcn_readfirstlane(tid >> 6);
    unsigned char* ws = a.ws;
    const int lo = a.ph_lo, hi = a.ph_hi, G = gridDim.x; int bid = blockIdx.x; bool xloc = false;
    volatile LAS unsigned* MISC = (volatile LAS unsigned*)(lds + 131072 + 320);
    if (tid < 64) MISC[tid] = 0u;
    __syncthreads();
    XcdBarrier bar; bar.bar = (unsigned*)ws; bar.x = 0; bar.st = MISC + 8; bar.rank = 0u;
    if (COOP) bar = xcd_barrier_post((unsigned*)ws, MISC + 8);
#ifndef PHASE_MASK
#define PHASE_MASK 0x3ff
#endif
#define IN(k) (((PHASE_MASK >> (k)) & 1) && lo <= (k) && (k) < hi)
#define NEXTP(k) ((k) == 2 ? 5 : (k) + 1)
#ifndef REP_MASK
#define REP_MASK 0
#endif
#define RP(k) (((REP_MASK >> (k)) & 1) ? 3 : 1)
#ifndef EXTRA_SYNCS
#define EXTRA_SYNCS 0
#endif
#define REPS(k) for (int rep_ = 0; rep_ < (((REP_MASK >> (k)) & 1) ? 3 : 1); ++rep_)
#define SYNC(k) do { if (COOP && IN(k) && IN(NEXTP(k))) { xcd_barrier(bar); } } while (0)
    if (IN(0)) { phase0(a, lds, tid, lane, wave); __syncthreads(); }
    if (COOP && tid == 0) MISC[10] = bar.rank;
    SYNC(0);
    if (COOP && lo == 0 && G == 256) {
        if (tid == 0) { unsigned ok = 1u; for (unsigned j = 0; j < 16; ++j) { const unsigned c = xb_ld(&bar.bar[XB_XCNT(j)]); if (c != (j < 8 ? 32u : 0u)) ok = 0u; } MISC[11] = ok; }
        __syncthreads();
        if (MISC[11] != 0u && bar.x < 8u && MISC[10] < 32u) { xloc = true; bid = (int)(MISC[10] * 8u + bar.x); }
    }
    if (IN(1)) {
        pg8::Gemm g{(const bf16_t*)(ws + WS_Z1), (const bf16_t*)(ws + WS_WINT), D, D, D, 0, 0};
        pg8::Order S; S.init(MROWS / 256, 1536 / 256, 1, G, bid, RP(1));
        pg8::EpiIn E{(bf16_t*)(ws + WS_UC), (bf16_t*)(ws + WS_AS), (bf16_t*)(ws + WS_SMALL + SM_UMETA), (const float*)(ws + WS_SMALL + SM_RS1)};
        pg8::gemm_phase<pg8::EpiIn>(lds, g, S, E);
        const int n2 = S.nwg - (S.nwg / G) * G;
        if (n2 == 0 || bid >= n2) { const int sidx = n2 == 0 ? bid : bid - n2, scnt = n2 == 0 ? G : G - n2;
            phase_toeplitz(a, tid, sidx, scnt);
            phase_transposes(a, lds, lane, wave, sidx * 8 + wave, scnt * 8, 768, 5504); }
    }
    SYNC(1);
    if (IN(2)) {
        unsigned* flags = (unsigned*)(ws + 49152);
        if (bid < 128) {
            const int xcd = bid & 7, j = bid >> 3, gg = xcd * 4 + (j >> 2), pm = (j >> 1) & 1, pn = j & 1;
            __syncthreads();
            if (bid < 64) phase_conv(a, lds, tid, lane, wave, bid, 192, 64); else phase_conv(a, lds, tid, lane, wave, 192 + (bid - 64), 320, 64);
            __syncthreads();
            pg8::Gemm g{(const bf16_t*)(ws + WS_AS), (const bf16_t*)(ws + WS_BTS), KS, KS, KS, (size_t)512 * KS, (size_t)512 * KS};
            pg8::OneUnit S{{pm, pn, gg}, flags + 64 * (gg * 2 + pm), 6, xloc}; pg8::EpiSsm E{(const bf16_t*)(ws + WS_AS), a.in[I_DSK], (bf16_t*)(ws + WS_YG)};
            pg8::gemm_phase<pg8::EpiSsm, pg8::OneUnit>(lds, g, S, E);
        } else if (bid < 192) {
            const int xcd = bid & 7, j = (bid - 128) >> 3, gg = xcd * 4 + (j >> 1), pm = j & 1;
            __syncthreads();
            { pg8::Gemm g{(const bf16_t*)(ws + WS_AS), (const bf16_t*)(ws + WS_WST), KS, 512, 512, (size_t)512 * KS, (size_t)256 * 512};
              pg8::OneUnit S{{pm, 0, gg}, nullptr, -1, false}; pg8::EpiSL E{(float*)(ws + WS_SL)};
              pg8::gemm_phase<pg8::EpiSL, pg8::OneUnit>(lds, g, S, E); }
            asm volatile("s_waitcnt vmcnt(0)" ::: "memory"); __syncthreads();
            if (tid < 256) scan_one(a, 2 * pm + (tid >> 7), gg, (tid >> 6) & 1, tid & 63);
            asm volatile("s_waitcnt vmcnt(0)" ::: "memory"); __syncthreads();
            if (tid == 0) { if (!xloc) { __builtin_amdgcn_fence(__ATOMIC_RELEASE, "agent"); asm volatile("s_waitcnt vmcnt(0)" ::: "memory"); }
                __hip_atomic_store(flags + 64 * (gg * 2 + pm), 1u, __ATOMIC_RELAXED, __HIP_MEMORY_SCOPE_AGENT); }
            phase_conv(a, lds, tid, lane, wave, 320 + (bid - 128), 512, 64);
        } else {
            __syncthreads();
            phase_conv(a, lds, tid, lane, wave, 512 + (bid - 192), 1024, 64);
        }
    }
    SYNC(2);
    if (IN(5)) {
        __syncthreads();
        pg8::Gemm g{(const bf16_t*)(ws + WS_YG), (const bf16_t*)(ws + WS_GLUT), DS, DS, DS, 0, 0};
        pg8::Order S; S.init(NTOK / 256, 2, 1, G, bid, RP(5));
        pg8::EpiGlu E{(const bf16_t*)(ws + WS_YG), a.in[I_GLUB], (bf16_t*)(ws + WS_MIXED)};
        pg8::gemm_phase<pg8::EpiGlu>(lds, g, S, E);
    }
    if (xloc) xcc_local_barrier(bar, 32u, false); else SYNC(5);
    if (IN(6)) {
        __syncthreads();
        pg8::Gemm g{(const bf16_t*)(ws + WS_MIXED), (const bf16_t*)(ws + WS_WOUTT), D, D, D, 0, 0};
        pg8::Order S; S.init(NTOK / 256, 4, 1, G, bid, RP(6));
        pg8::EpiOut E{(const bf16_t*)(ws + WS_Z1), (bf16_t*)(ws + WS_H2B), (float*)(ws + WS_PS)};
        pg8::gemm_phase<pg8::EpiOut>(lds, g, S, E);
        if (tid == 0) __hip_atomic_fetch_add((unsigned*)(ws + 65536), 1u, __ATOMIC_RELAXED, __HIP_MEMORY_SCOPE_AGENT);
    }
    if (xloc) xcc_local_barrier(bar, 32u, false); else SYNC(6);
    if (IN(7)) {
        pg8::Gemm g{(const bf16_t*)(ws + WS_H2B), (const bf16_t*)(ws + WS_W1T), D, D, D, 0, 0};
        pg8::Order S; S.init(NTOK / 256, DFF / 256, 1, G, bid, RP(7));
        pg8::EpiFF1 E{(const float*)(ws + WS_PS), (bf16_t*)(ws + WS_HID), (const unsigned*)(ws + 65536), (unsigned)G};
        pg8::gemm_phase<pg8::EpiFF1>(lds, g, S, E);
    }
    if (xloc) xcc_local_barrier(bar, 32u, true); else SYNC(7);
    if (IN(8)) {
        pg8::Gemm g{(const bf16_t*)(ws + WS_HID), (const bf16_t*)(ws + WS_W2T), DFF, DFF, DFF, 0, 0};
        pg8::Order S; S.init(NTOK / 256, 4, 1, G, bid);
        pg8::EpiFinal E{a.out, (const bf16_t*)(ws + WS_H2B), (float*)(ws + WS_PS2), (unsigned*)(ws + 32768), a.in[I_GF], (const float*)(ws + WS_PS), xloc};
        pg8::gemm_phase<pg8::EpiFinal>(lds, g, S, E);
    }

#undef IN
#undef SYNC
}

extern "C" void kernel_launch(void* const* d_in, const int* in_sizes, int n_in, void* d_out, int out_size, void* d_ws, size_t ws_size, hipStream_t stream) {
    static int grid = 0;
    if (grid == 0) {
        if (n_in != 23 || out_size != NTOK * D || ws_size < WS_END) { fprintf(stderr, "kernel_launch: unexpected problem (n_in %d out %d ws %zu)\n", n_in, out_size, ws_size); grid = -1; return; }
        int dev = 0, cus = 0, per_cu = 0;
        hipGetDevice(&dev); hipDeviceGetAttribute(&cus, hipDeviceAttributeMultiprocessorCount, dev);
        hipFuncSetAttribute((const void*)fwd_kernel<true>, hipFuncAttributeMaxDynamicSharedMemorySize, LDS_BYTES);
        hipFuncSetAttribute((const void*)fwd_kernel<false>, hipFuncAttributeMaxDynamicSharedMemorySize, LDS_BYTES);
        hipOccupancyMaxActiveBlocksPerMultiprocessor(&per_cu, (const void*)fwd_kernel<true>, 512, LDS_BYTES);
        if (per_cu < 1) { fprintf(stderr, "kernel_launch: the occupancy query reports %d workgroups per CU for this kernel + %d B of LDS: a resident grid is impossible, nothing launched\n", per_cu, LDS_BYTES); grid = -1; return; }
        (void)hipGetLastError();
        grid = cus;
        if (grid < 256) { fprintf(stderr, "kernel_launch: this kernel's phase program needs >= 256 CUs (got %d)\n", cus); grid = -1; return; }
    }
    if (grid < 0) return;
    Args a{};
    for (int i = 0; i < 23; ++i) a.in[i] = (const float*)d_in[i];
    a.out = (float*)d_out; a.ws = (unsigned char*)d_ws;
#if MK_MULTI
    for (int p = 0; p < NPHASE; ++p) { a.ph_lo = p; a.ph_hi = p + 1; hipLaunchKernelGGL(fwd_kernel<false>, dim3(grid), dim3(512), LDS_BYTES, stream, a); }
#else
    a.ph_lo = 0; a.ph_hi = NPHASE;
    if (hipMemsetAsync(d_ws, 0, 131072, stream) != hipSuccess) { fprintf(stderr, "kernel_launch: memset of barrier words failed\n"); return; }
    void* args[] = {&a};
    hipError_t e = hipLaunchCooperativeKernel((const void*)fwd_kernel<true>, dim3(grid), dim3(512), args, LDS_BYTES, stream);
    if (e != hipSuccess) fprintf(stderr, "cooperative launch failed: %s (grid %d)\n", hipGetErrorString(e), grid);
#endif
}
```

```cpp
#include <hip/hip_runtime.h>
#include <hip/hip_cooperative_groups.h>
#include <cstdio>
#include <cstdint>
namespace cg = cooperative_groups;

#define LAS __attribute__((address_space(3)))
typedef unsigned short bf16_t;
typedef short bf16x8 __attribute__((ext_vector_type(8)));
typedef float f32x4 __attribute__((ext_vector_type(4)));
typedef float f32x2 __attribute__((ext_vector_type(2)));
typedef unsigned u32x4 __attribute__((ext_vector_type(4)));
typedef unsigned u32x2 __attribute__((ext_vector_type(2)));

#ifndef MK_MULTI
#define MK_MULTI 0
#endif

constexpr int D = 1024, NTOK = 16384, SEQ = 4096, MROWS = 16640  ;
constexpr int DC = 512, DS = 512, NG = 32, TCH = 32, NCH = 128  , KS = 768  ;
constexpr int DFF = 4096;
constexpr float EPS = 1e-5f;
constexpr size_t MiB = 1u << 20;
constexpr size_t WS_W1T = 1 * MiB, WS_W2T = 9 * MiB, WS_WOUTT = 17 * MiB, WS_WINT = 19 * MiB, WS_GLUT = 22 * MiB, WS_PS = 23 * MiB, WS_PS2 = 24 * MiB,
                 WS_SMALL = 25 * MiB, WS_KT = 26 * MiB, WS_H2B = 28 * MiB, WS_HID = 60 * MiB, WS_Z1 = 60 * MiB, WS_UC = 93 * MiB, WS_AS = 110 * MiB,
                 WS_BTS = 134 * MiB, WS_SL = 158 * MiB, WS_WST = 174 * MiB, WS_MIXED = 188 * MiB, WS_YG = 220 * MiB, WS_END = 236 * MiB;
constexpr size_t SM_UMETA = 0  , SM_LBF = 32768  , SM_LAMT = 65536  , SM_BBF = 131072  , SM_RS1 = 524288  ;

constexpr int LDS_BYTES = 147456;

__device__ __forceinline__ unsigned f2bf(float f) { unsigned u = __builtin_bit_cast(unsigned, f); return (u + 0x7fffu + ((u >> 16) & 1u)) >> 16; }
__device__ __forceinline__ unsigned pk2(float lo, float hi) { return f2bf(lo) | (f2bf(hi) << 16); }
__device__ __forceinline__ unsigned cvt_pk_bf16(float lo, float hi) { unsigned r; asm volatile("v_cvt_pk_bf16_f32 %0, %1, %2" : "=v"(r) : "v"(lo), "v"(hi)); return r; }
__device__ __forceinline__ float bflo(unsigned w) { return __builtin_bit_cast(float, w << 16); }
__device__ __forceinline__ float bfhi(unsigned w) { return __builtin_bit_cast(float, w & 0xffff0000u); }
__device__ __forceinline__ float wave_sum(float v) {
#pragma unroll
    for (int o = 1; o < 64; o <<= 1) v += __shfl_xor(v, o);
    return v;
}
__device__ __forceinline__ float sigmoidf_(float x) { return __builtin_amdgcn_rcpf(1.0f + __expf(-x)); }
__device__ __forceinline__ float gelu_tanh(float x) { const float u = 1.5957691216f * (x + 0.044715f * x * x * x); return x * sigmoidf_(u); }

__device__ __forceinline__ void sincos_d(double a, double& s, double& c) {
    const double k = rint(a * 0.15915494309189535); double r = fma(-k, 6.283185307179586, a); r = fma(-k, 2.4492935982947064e-16, r);
    const double q = r * 0.25, q2 = q * q;
    double sq = q * (1.0 + q2 * (-1.0 / 6 + q2 * (1.0 / 120 + q2 * (-1.0 / 5040 + q2 * (1.0 / 362880 + q2 * (-1.0 / 39916800 + q2 * (1.0 / 6227020800.0)))))));
    double cq = 1.0 + q2 * (-0.5 + q2 * (1.0 / 24 + q2 * (-1.0 / 720 + q2 * (1.0 / 40320 + q2 * (-1.0 / 3628800 + q2 * (1.0 / 479001600.0 + q2 * (-1.0 / 87178291200.0)))))));
    const double s2 = 2.0 * sq * cq, c2 = 1.0 - 2.0 * sq * sq;
    s = 2.0 * s2 * c2; c = 1.0 - 2.0 * s2 * s2;
}

namespace pg8 {
constexpr int BM = 256, BK = 64, HALF = 128, HTB = HALF * BK * 2, STAGE_BYTES = 8 * HTB, NXCD = 8, WGM = 8;
__device__ __forceinline__ int lds_byte(int r, int c) { const int st = (r >> 4) * 2 + (c >> 5), rr = r & 15, cc = c & 31, ob = rr * 64 + cc * 2; return st * 1024 + (ob ^ (((ob >> 9) & 1) << 5)); }
__device__ __forceinline__ void stage_rc(int b, int& R, int& C) { const int st = b / 1024, sb = b % 1024, swz = sb ^ (((sb >> 9) & 1) << 5); R = (st >> 1) * 16 + swz / 64; C = (st & 1) * 32 + (swz % 64) / 2; }
__device__ __forceinline__ int perm32(int rho) { const int n = rho >> 4, i = rho & 15; return 8 * (i >> 2) + 4 * n + (i & 3); }

struct Unit { int pm, pn, g; };
struct Gemm { const bf16_t* A; const bf16_t* Bt; int lda, ldb, K; size_t gsA, gsB; };

struct Order {
    static constexpr bool HASWAIT = false;
    __device__ __forceinline__ void kwait(int) const {}
    int nM, nN, nG, nwg, G, c, rep;
    __device__ void init(int nM_, int nN_, int nG_, int G_, int c_, int rep_ = 1) { nM = nM_; nN = nN_; nG = nG_; nwg = nM * nN * nG; G = G_; c = c_; rep = rep_; }
    __device__ bool next(int i, Unit& u) const {
        long L = (long)i * G + c; if (L >= (long)nwg * rep) return false; L %= nwg;
        if (nG == 1) {
            int wgid = (int)L; { const int q = nwg / NXCD, r = nwg % NXCD, xcd = wgid % NXCD, off = wgid / NXCD; wgid = (xcd < r ? xcd * (q + 1) : r * (q + 1) + (xcd - r) * q) + off; }
            const int nig = WGM * nN, gid = wgid / nig, fm = gid * WGM, gsz = (nM - fm) < WGM ? (nM - fm) : WGM;
            u.pm = fm + ((wgid % nig) % gsz); u.pn = (wgid % nig) / gsz; u.g = 0;
        } else {
            const int per = nM * nN, l = (int)L; u.g = l / per; const int r = l % per; u.pm = r % nM; u.pn = r / nM;
        }
        return true;
    }
};

struct OneUnit {
    static constexpr bool HASWAIT = true;
    Unit u; const unsigned* flag; int wait_t; bool samexcc;
    __device__ __forceinline__ bool next(int i, Unit& o) const { if (i > 0) return false; o = u; return true; }
    __device__ __forceinline__ void kwait(int t) const {
        if (flag == nullptr || t != wait_t) return;
        unsigned spins = 0;
        while ((unsigned)__builtin_amdgcn_readfirstlane(__hip_atomic_load(flag, __ATOMIC_RELAXED, __HIP_MEMORY_SCOPE_AGENT)) == 0u) { __builtin_amdgcn_s_sleep(2); if (++spins > (1u << 22)) break; }
        if (!samexcc) { __builtin_amdgcn_fence(__ATOMIC_ACQUIRE, "agent"); asm volatile("s_waitcnt vmcnt(0)" ::: "memory"); }
        else asm volatile("" ::: "memory");
    }
};

template <class Epi, class Sched = Order, bool ALIGN_EPI = true>
__device__ __forceinline__ void gemm_phase(LAS unsigned char* lds, const Gemm g, const Sched& S, const Epi& E) {
    const int tid = threadIdx.x, wid = __builtin_amdgcn_readfirstlane(tid >> 6), lane = tid & 63, wr = wid >> 2, wc = wid & 3, fr = lane & 15, fq = lane >> 4;
    const int K = g.K, nt = K / BK;
    unsigned voffA[2], voffB[2];
#pragma unroll
    for (int i = 0; i < 2; ++i) { int R, C; stage_rc(tid * 16 + i * 8192, R, C); const int Rb = Epi::PERM ? ((R & ~31) + perm32(R & 31)) : R;
        voffA[i] = (unsigned)(R * g.lda + C) * 2u; voffB[i] = (unsigned)(Rb * g.ldb + C) * 2u; }
    const size_t kstep = (size_t)(BK * 2);
    const size_t hstepA = (size_t)HALF * g.lda * 2, hstepB = (size_t)HALF * g.ldb * 2;
    const unsigned ldsw = (unsigned)wid * 1024u;
    const int aoff = lds_byte(wr * 64 + fr, fq * 8), boff = lds_byte(wc * 32 + fr, fq * 8);
#define PG8_SA(b, h) (((b) * 2 + (h)) * HTB)
#define PG8_SB(b, h) ((4 + (b) * 2 + (h)) * HTB)
#define PG8_STAGE(bufoff, gbase, voff) do { _Pragma("unroll") for (int _i = 0; _i < 2; ++_i) \
        __builtin_amdgcn_global_load_lds((const unsigned*)((const char*)(gbase) + (voff)[_i]), (LAS unsigned*)(lds + (bufoff) + ldsw + _i * 8192), 16, 0, 0); } while (0)
#define PG8_LDA(dst, b, h) do { _Pragma("unroll") for (int m = 0; m < 4; ++m) _Pragma("unroll") for (int k = 0; k < 2; ++k) dst[m][k] = *(const LAS bf16x8*)(lds + PG8_SA(b, h) + aoff + m * 2048 + k * 1024); } while (0)
#define PG8_LDB(dst, b, h) do { _Pragma("unroll") for (int n = 0; n < 2; ++n) _Pragma("unroll") for (int k = 0; k < 2; ++k) dst[n][k] = *(const LAS bf16x8*)(lds + PG8_SB(b, h) + boff + n * 2048 + k * 1024); } while (0)
#define PG8_MMA(ai, bj, At, Bt) do { __builtin_amdgcn_s_setprio(1); _Pragma("unroll") for (int m = 0; m < 4; ++m) _Pragma("unroll") for (int n = 0; n < 2; ++n) _Pragma("unroll") for (int k = 0; k < 2; ++k) \
        acc[ai][bj][m][n] = __builtin_amdgcn_mfma_f32_16x16x32_bf16(Bt[n][k], At[m][k], acc[ai][bj][m][n], 0, 0, 0); __builtin_amdgcn_s_setprio(0); } while (0)
#define PG8_WAIT_V(n) asm volatile("s_waitcnt vmcnt(" #n ")" ::: "memory")
#define PG8_WAIT_L(n) asm volatile("s_waitcnt lgkmcnt(" #n ")" ::: "memory")
#define PG8_BAR __builtin_amdgcn_s_barrier()
#define PG8_SCHED __builtin_amdgcn_sched_barrier(0)
    Unit cur, nxt; int ui = 0;
    if (!S.next(0, cur)) return;
    f32x4 acc[2][2][4][2];
#pragma unroll
    for (int a = 0; a < 2; ++a)
#pragma unroll
        for (int b = 0; b < 2; ++b)
#pragma unroll
            for (int m = 0; m < 4; ++m)
#pragma unroll
                for (int n = 0; n < 2; ++n) acc[a][b][m][n] = (f32x4){0.f, 0.f, 0.f, 0.f};
    bf16x8 At[4][2], B0[2][2], B1[2][2];
    const char* cA = (const char*)(g.A + (size_t)cur.g * g.gsA + (size_t)cur.pm * BM * g.lda);
    const char* cB = (const char*)(g.Bt + (size_t)cur.g * g.gsB + (size_t)cur.pn * BM * g.ldb);
    PG8_STAGE(PG8_SB(0, 0), cB, voffB); PG8_STAGE(PG8_SB(0, 1), cB + hstepB, voffB); PG8_STAGE(PG8_SA(0, 0), cA, voffA); PG8_STAGE(PG8_SA(0, 1), cA + hstepA, voffA);
    if (wr == 1) PG8_BAR;
    PG8_WAIT_V(2); PG8_BAR;
    PG8_STAGE(PG8_SB(1, 0), cB + kstep, voffB); PG8_STAGE(PG8_SA(1, 0), cA + kstep, voffA); PG8_STAGE(PG8_SB(1, 1), cB + hstepB + kstep, voffB);
    PG8_WAIT_V(6); PG8_BAR;
    for (;;) {
        const bool has_next = S.next(ui + 1, nxt);
        const char* nA = has_next ? (const char*)(g.A + (size_t)nxt.g * g.gsA + (size_t)nxt.pm * BM * g.lda) : cA;
        const char* nB = has_next ? (const char*)(g.Bt + (size_t)nxt.g * g.gsB + (size_t)nxt.pn * BM * g.ldb) : cB;
        for (int t = 0; t < nt; t += 2) {
            if constexpr (Sched::HASWAIT) S.kwait(t);
            const bool last = (t == nt - 2);
            const char* a1 = cA + (size_t)(t + 1) * kstep;
            const char* a2 = last ? nA : cA + (size_t)(t + 2) * kstep; const char* b2 = last ? nB : cB + (size_t)(t + 2) * kstep;
            const char* a3 = a2 + kstep; const char* b3 = b2 + kstep;
            PG8_LDB(B0, 0, 0); PG8_LDB(B1, 0, 1); PG8_SCHED; PG8_LDA(At, 0, 0); PG8_STAGE(PG8_SA(1, 1), a1 + hstepA, voffA);
            PG8_WAIT_V(8); PG8_WAIT_L(0); PG8_BAR; PG8_MMA(0, 0, At, B0); PG8_MMA(0, 1, At, B1); PG8_BAR; PG8_SCHED;
            PG8_LDA(At, 0, 1); PG8_STAGE(PG8_SB(0, 0), b2, voffB); PG8_STAGE(PG8_SB(0, 1), b2 + hstepB, voffB); PG8_STAGE(PG8_SA(0, 0), a2, voffA);
            PG8_WAIT_V(8); PG8_WAIT_L(0); PG8_BAR; PG8_MMA(1, 0, At, B0); PG8_MMA(1, 1, At, B1); PG8_BAR; PG8_SCHED;
            PG8_LDB(B0, 1, 0); PG8_LDB(B1, 1, 1); PG8_SCHED; PG8_LDA(At, 1, 0); PG8_STAGE(PG8_SA(0, 1), a2 + hstepA, voffA);
            PG8_WAIT_V(8); PG8_WAIT_L(0); PG8_BAR; PG8_MMA(0, 0, At, B0); PG8_MMA(0, 1, At, B1); PG8_BAR; PG8_SCHED;
            PG8_LDA(At, 1, 1); PG8_STAGE(PG8_SB(1, 0), b3, voffB); PG8_STAGE(PG8_SB(1, 1), b3 + hstepB, voffB); PG8_STAGE(PG8_SA(1, 0), a3, voffA);
            PG8_WAIT_V(8); PG8_WAIT_L(0); PG8_BAR; PG8_MMA(1, 0, At, B0); PG8_MMA(1, 1, At, B1); PG8_BAR; PG8_SCHED;
        }
        if constexpr (ALIGN_EPI) { if (wr == 0) PG8_BAR; }
        E(acc, cur, wr, wc, fr, fq);
        if (!has_next) break;
#pragma unroll
        for (int a = 0; a < 2; ++a)
#pragma unroll
            for (int b = 0; b < 2; ++b)
#pragma unroll
                for (int m = 0; m < 4; ++m)
#pragma unroll
                    for (int n = 0; n < 2; ++n) acc[a][b][m][n] = (f32x4){0.f, 0.f, 0.f, 0.f};
        cur = nxt; cA = nA; cB = nB; ++ui;
        if constexpr (ALIGN_EPI) { if (wr == 1) PG8_BAR; }
    }
    PG8_WAIT_V(0);
    if constexpr (!ALIGN_EPI) { if (wr == 0) PG8_BAR; }
    PG8_BAR;
#undef PG8_SA
#undef PG8_SB
#undef PG8_STAGE
#undef PG8_LDA
#undef PG8_LDB
#undef PG8_MMA
#undef PG8_WAIT_V
#undef PG8_WAIT_L
#undef PG8_BAR
#undef PG8_SCHED
}

typedef f32x4 Acc[2][2][4][2];

struct EpiIn {
    static constexpr bool PERM = true;
    bf16_t* UC; bf16_t* AS; bf16_t* UMETA; const float* RS1;
    __device__ __forceinline__ void operator()(const Acc& acc, const Unit& u, int wr, int wc, int fr, int fq) const {
        const int row0 = u.pm * BM + wr * 64 + fr;
        float rsv[2][4];
#pragma unroll
        for (int ai = 0; ai < 2; ++ai)
#pragma unroll
            for (int m = 0; m < 4; ++m) rsv[ai][m] = RS1[row0 + ai * HALF + m * 16];
        if (u.pn < 4) {
            const int ch0 = u.pn * 128 + wc * 32 + 8 * fq;
#pragma unroll
            for (int ai = 0; ai < 2; ++ai)
#pragma unroll
                for (int m = 0; m < 4; ++m) {
                    const int row = row0 + ai * HALF + m * 16;
                    const float rs = rsv[ai][m];
                    const f32x4 v0 = acc[ai][0][m][0] * rs, v1 = acc[ai][0][m][1] * rs, g0 = acc[ai][1][m][0] * rs, g1 = acc[ai][1][m][1] * rs;
                    u32x4 w;
                    w.x = cvt_pk_bf16(v0[0] * sigmoidf_(g0[0]), v0[1] * sigmoidf_(g0[1])); w.y = cvt_pk_bf16(v0[2] * sigmoidf_(g0[2]), v0[3] * sigmoidf_(g0[3]));
                    w.z = cvt_pk_bf16(v1[0] * sigmoidf_(g1[0]), v1[1] * sigmoidf_(g1[1])); w.w = cvt_pk_bf16(v1[2] * sigmoidf_(g1[2]), v1[3] * sigmoidf_(g1[3]));
                    *(u32x4*)(UC + (size_t)row * DC + ch0) = w;
                }
        } else {
#pragma unroll
            for (int bj = 0; bj < 2; ++bj) {
                const int c0 = (u.pn - 4) * 256 + bj * HALF + wc * 32 + 8 * fq, gg = c0 >> 4, hi0 = c0 & 15;
#pragma unroll
                for (int ai = 0; ai < 2; ++ai)
#pragma unroll
                    for (int m = 0; m < 4; ++m) {
                        const int row = row0 + ai * HALF + m * 16;
                        const float rs = rsv[ai][m];
                        const f32x4 v0 = acc[ai][bj][m][0] * rs, v1 = acc[ai][bj][m][1] * rs;
                        u32x4 w; w.x = cvt_pk_bf16(v0[0], v0[1]); w.y = cvt_pk_bf16(v0[2], v0[3]); w.z = cvt_pk_bf16(v1[0], v1[1]); w.w = cvt_pk_bf16(v1[2], v1[3]);
                        if (row < NTOK) { const int b = row >> 12, pos = row & 4095, ch = pos >> 5, s = pos & 31;
                            *(u32x4*)(AS + ((size_t)gg * 512 + b * NCH + ch) * KS + s * 16 + hi0) = w; }
                        else if (row < NTOK + 16) *(u32x4*)(UMETA + (size_t)(row - NTOK) * DS + c0) = w;
                    }
            }
        }
    }
};
struct EpiSL {
    static constexpr bool PERM = false;
    float* SL;
    __device__ __forceinline__ void operator()(const Acc& acc, const Unit& u, int wr, int wc, int fr, int fq) const {
        const int row0 = u.pm * BM + wr * 64 + fr, col0 = wc * 32 + 4 * fq;
#pragma unroll
        for (int ai = 0; ai < 2; ++ai)
#pragma unroll
            for (int m = 0; m < 4; ++m) { float* rowp = SL + ((size_t)u.g * 512 + row0 + ai * HALF + m * 16) * 256 + col0;
#pragma unroll
                for (int bj = 0; bj < 2; ++bj)
#pragma unroll
                    for (int n = 0; n < 2; ++n) *(f32x4*)(rowp + bj * HALF + n * 16) = acc[ai][bj][m][n]; }
    }
};
struct EpiSsm {
    static constexpr bool PERM = true;
    const bf16_t* AS; const float* Dsk; bf16_t* YG;
    __device__ __forceinline__ void operator()(const Acc& acc, const Unit& u, int wr, int wc, int fr, int fq) const {
        const int row0 = u.pm * BM + wr * 64 + fr, ho0 = (8 * fq) & 15;
        const f32x4 d0 = *(const f32x4*)(Dsk + u.g * 16 + ho0), d1 = *(const f32x4*)(Dsk + u.g * 16 + ho0 + 4);
#pragma unroll
        for (int ai = 0; ai < 2; ++ai) {
            u32x4 uv[1 + 0 * 2][4][2];
#pragma unroll
            for (int m = 0; m < 4; ++m)
#pragma unroll
                for (int bj = 0; bj < 2; ++bj) uv[0][m][bj] = *(const u32x4*)(AS + ((size_t)u.g * 512 + row0 + ai * HALF + m * 16) * KS + u.pn * BM + bj * HALF + wc * 32 + 8 * fq);
#pragma unroll
            for (int m = 0; m < 4; ++m) {
                const int r = row0 + ai * HALF + m * 16;
                const size_t tok0 = (size_t)(r >> 7) * SEQ + (size_t)(r & 127) * TCH;
#pragma unroll
                for (int bj = 0; bj < 2; ++bj) {
                    const int c = u.pn * BM + bj * HALF + wc * 32 + 8 * fq, t = c >> 4;
                    const u32x4 uu = uv[0][m][bj];
                    const f32x4 a0 = acc[ai][bj][m][0], a1 = acc[ai][bj][m][1];
                    float y[8];
                    y[0] = a0[0] + d0[0] * bflo(uu.x); y[1] = a0[1] + d0[1] * bfhi(uu.x); y[2] = a0[2] + d0[2] * bflo(uu.y); y[3] = a0[3] + d0[3] * bfhi(uu.y);
                    y[4] = a1[0] + d1[0] * bflo(uu.z); y[5] = a1[1] + d1[1] * bfhi(uu.z); y[6] = a1[2] + d1[2] * bflo(uu.w); y[7] = a1[3] + d1[3] * bfhi(uu.w);
#pragma unroll
                    for (int j = 0; j < 8; ++j) y[j] = gelu_tanh(y[j]);
                    u32x4 w; w.x = cvt_pk_bf16(y[0], y[1]); w.y = cvt_pk_bf16(y[2], y[3]); w.z = cvt_pk_bf16(y[4], y[5]); w.w = cvt_pk_bf16(y[6], y[7]);
                    *(u32x4*)(YG + (tok0 + t) * DS + u.g * 16 + ho0) = w;
                }
            }
        }
    }
};
struct EpiGlu {
    static constexpr bool PERM = true;
    const bf16_t* YG; const float* bias; bf16_t* MIXED;
    __device__ __forceinline__ void operator()(const Acc& acc, const Unit& u, int wr, int wc, int fr, int fq) const {
        const int row0 = u.pm * BM + wr * 64 + fr;
        f32x4 bv[2][2];
#pragma unroll
        for (int bj = 0; bj < 2; ++bj) { const int c = u.pn * BM + bj * HALF + wc * 32 + 8 * fq; bv[bj][0] = *(const f32x4*)(bias + c); bv[bj][1] = *(const f32x4*)(bias + c + 4); }
#pragma unroll
        for (int ai = 0; ai < 2; ++ai) {
            u32x4 yv[2][4];
#pragma unroll
            for (int bj = 0; bj < 2; ++bj)
#pragma unroll
                for (int m = 0; m < 4; ++m) yv[bj][m] = *(const u32x4*)(YG + (size_t)(row0 + ai * HALF + m * 16) * DS + u.pn * BM + bj * HALF + wc * 32 + 8 * fq);
#pragma unroll
            for (int bj = 0; bj < 2; ++bj) {
                const int c = u.pn * BM + bj * HALF + wc * 32 + 8 * fq;
                const f32x4 b0 = bv[bj][0], b1 = bv[bj][1];
#pragma unroll
                for (int m = 0; m < 4; ++m) {
                    const int row = row0 + ai * HALF + m * 16;
                    const u32x4 yy = yv[bj][m];
                    const f32x4 a0 = acc[ai][bj][m][0] + b0, a1 = acc[ai][bj][m][1] + b1;
                    u32x4 w;
                    w.x = cvt_pk_bf16(bflo(yy.x) * sigmoidf_(a0[0]), bfhi(yy.x) * sigmoidf_(a0[1])); w.y = cvt_pk_bf16(bflo(yy.y) * sigmoidf_(a0[2]), bfhi(yy.y) * sigmoidf_(a0[3]));
                    w.z = cvt_pk_bf16(bflo(yy.z) * sigmoidf_(a1[0]), bfhi(yy.z) * sigmoidf_(a1[1])); w.w = cvt_pk_bf16(bflo(yy.w) * sigmoidf_(a1[2]), bfhi(yy.w) * sigmoidf_(a1[3]));
                    *(u32x4*)(MIXED + (size_t)row * D + DC + c) = w;
                }
            }
        }
    }
};
struct EpiOut {
    static constexpr bool PERM = true;
    const bf16_t* XB; bf16_t* HB; float* PS;
    __device__ __forceinline__ void operator()(const Acc& acc, const Unit& u, int wr, int wc, int fr, int fq) const {
        const int row0 = u.pm * BM + wr * 64 + fr;
#pragma unroll
        for (int ai = 0; ai < 2; ++ai) {
            u32x4 xv[1][4][2];
#pragma unroll
            for (int m = 0; m < 4; ++m)
#pragma unroll
                for (int bj = 0; bj < 2; ++bj) xv[0][m][bj] = *(const u32x4*)(XB + (size_t)(row0 + ai * HALF + m * 16) * D + u.pn * BM + bj * HALF + wc * 32 + 8 * fq);
#pragma unroll
            for (int m = 0; m < 4; ++m) {
                const int row = row0 + ai * HALF + m * 16; float ss = 0.f;
#pragma unroll
                for (int bj = 0; bj < 2; ++bj) {
                    const size_t off = (size_t)row * D + u.pn * BM + bj * HALF + wc * 32 + 8 * fq;
                    const u32x4 xb = xv[0][m][bj];
                    const f32x4 h0 = (f32x4){bflo(xb.x), bfhi(xb.x), bflo(xb.y), bfhi(xb.y)} + acc[ai][bj][m][0], h1 = (f32x4){bflo(xb.z), bfhi(xb.z), bflo(xb.w), bfhi(xb.w)} + acc[ai][bj][m][1];
                    u32x4 w; w.x = cvt_pk_bf16(h0[0], h0[1]); w.y = cvt_pk_bf16(h0[2], h0[3]); w.z = cvt_pk_bf16(h1[0], h1[1]); w.w = cvt_pk_bf16(h1[2], h1[3]); *(u32x4*)(HB + off) = w;
                    ss += (h0[0] * h0[0] + h0[1] * h0[1]) + (h0[2] * h0[2] + h0[3] * h0[3]) + (h1[0] * h1[0] + h1[1] * h1[1]) + (h1[2] * h1[2] + h1[3] * h1[3]);
                }
                ss += __shfl_xor(ss, 16); ss += __shfl_xor(ss, 32);
                if (fq == 0) PS[(size_t)row * 16 + u.pn * 4 + wc] = ss;
            }
        }
    }
};
struct EpiFF1 {
    static constexpr bool PERM = true;
    const float* PS; bf16_t* HID; const unsigned* p6done; unsigned need; volatile LAS unsigned* relay;
    __device__ __forceinline__ void operator()(const Acc& acc, const Unit& u, int wr, int wc, int fr, int fq) const {
        const int row0 = u.pm * BM + wr * 64 + fr;
        if (u.pn < 4) {
            if (threadIdx.x < 64) { unsigned spins = 0; while ((unsigned)__builtin_amdgcn_readfirstlane(__hip_atomic_load(p6done, __ATOMIC_RELAXED, __HIP_MEMORY_SCOPE_AGENT)) < need) { __builtin_amdgcn_s_sleep(2); if (++spins > (1u << 22)) break; }
                if (threadIdx.x == 0) relay[0] = 1u; }
            else { unsigned spins = 0; while (relay[0] == 0u) { __builtin_amdgcn_s_sleep(1); if (++spins > (1u << 24)) break; } }
            asm volatile("" ::: "memory");
        }
#pragma unroll
        for (int ai = 0; ai < 2; ++ai)
#pragma unroll
            for (int m = 0; m < 4; ++m) {
                const int row = row0 + ai * HALF + m * 16;
#pragma unroll
                for (int bj = 0; bj < 2; ++bj) {
                    const size_t off = (size_t)row * DFF + u.pn * BM + bj * HALF + wc * 32 + 8 * fq;
                    float y[8];
#pragma unroll
                    for (int j = 0; j < 4; ++j) { const float a = fmaxf(acc[ai][bj][m][0][j], 0.f), b = fmaxf(acc[ai][bj][m][1][j], 0.f); y[j] = a * a; y[4 + j] = b * b; }
                    u32x4 w; w.x = cvt_pk_bf16(y[0], y[1]); w.y = cvt_pk_bf16(y[2], y[3]); w.z = cvt_pk_bf16(y[4], y[5]); w.w = cvt_pk_bf16(y[6], y[7]);
                    *(u32x4*)(HID + off) = w;
                }
            }
    }
};
struct EpiFinal {
    static constexpr bool PERM = true;
    float* OUT; const bf16_t* HB; float* PS2; unsigned* cnt; const float* gf; const float* PS; bool local;
    __device__ __forceinline__ void operator()(Acc& acc, const Unit& u, int wr, int wc, int fr, int fq) const {
        const int row0 = u.pm * BM + wr * 64 + fr, col0 = u.pn * BM + wc * 32 + 8 * fq;
#pragma unroll
        for (int ai = 0; ai < 2; ++ai) {
            u32x4 hv[4][2]; f32x4 pv[4];
#pragma unroll
            for (int m = 0; m < 4; ++m) { const int row = row0 + ai * HALF + m * 16; pv[m] = *(const f32x4*)(PS + (size_t)row * 16 + fq * 4);
#pragma unroll
                for (int bj = 0; bj < 2; ++bj) hv[m][bj] = *(const u32x4*)(HB + (size_t)row * D + col0 + bj * HALF); }
#pragma unroll
            for (int m = 0; m < 4; ++m) {
                const int row = row0 + ai * HALF + m * 16; float ss = 0.f;
                const f32x4 pq = pv[m];
                float sq = (pq[0] + pq[1]) + (pq[2] + pq[3]); sq += __shfl_xor(sq, 16); sq += __shfl_xor(sq, 32);
                const float rs2 = __builtin_amdgcn_rcpf(sq * (1.0f / D) + EPS);
#pragma unroll
                for (int bj = 0; bj < 2; ++bj) {
                    const size_t off = (size_t)row * D + col0 + bj * HALF;
                    const u32x4 hb = hv[m][bj];
                    const f32x4 h0 = (f32x4){bflo(hb.x), bfhi(hb.x), bflo(hb.y), bfhi(hb.y)} + acc[ai][bj][m][0] * rs2, h1 = (f32x4){bflo(hb.z), bfhi(hb.z), bflo(hb.w), bfhi(hb.w)} + acc[ai][bj][m][1] * rs2;
                    acc[ai][bj][m][0] = h0; acc[ai][bj][m][1] = h1;
                    ss += (h0[0] * h0[0] + h0[1] * h0[1]) + (h0[2] * h0[2] + h0[3] * h0[3]) + (h1[0] * h1[0] + h1[1] * h1[1]) + (h1[2] * h1[2] + h1[3] * h1[3]);
                }
                ss += __shfl_xor(ss, 16); ss += __shfl_xor(ss, 32);
                if (fq == 0) { if (local) PS2[(size_t)row * 16 + u.pn * 4 + wc] = ss; else __hip_atomic_store((unsigned*)(PS2 + (size_t)row * 16 + u.pn * 4 + wc), __builtin_bit_cast(unsigned, ss), __ATOMIC_RELAXED, __HIP_MEMORY_SCOPE_AGENT); }
            }
        }
        asm volatile("s_waitcnt vmcnt(0)" ::: "memory");
        unsigned* c = cnt + 64 * u.pm;
        if (fr == 0 && fq == 0) __hip_atomic_fetch_add(c, 1u, __ATOMIC_RELAXED, __HIP_MEMORY_SCOPE_AGENT);
        { unsigned spins = 0;
          while ((unsigned)__builtin_amdgcn_readfirstlane(__hip_atomic_load(c, __ATOMIC_RELAXED, __HIP_MEMORY_SCOPE_AGENT)) < 32u) { __builtin_amdgcn_s_sleep(2); if (++spins > (1u << 22)) break; } }
        if (!local) __builtin_amdgcn_fence(__ATOMIC_ACQUIRE, "agent");
        else asm volatile("" ::: "memory");
        f32x4 gg[2][2];
#pragma unroll
        for (int bj = 0; bj < 2; ++bj) { gg[bj][0] = *(const f32x4*)(gf + col0 + bj * HALF); gg[bj][1] = *(const f32x4*)(gf + col0 + bj * HALF + 4); }
#pragma unroll
        for (int ai = 0; ai < 2; ++ai) {
            unsigned qv[4][4];
#pragma unroll
            for (int m = 0; m < 4; ++m) { const unsigned* ps = (const unsigned*)(PS2 + (size_t)(row0 + ai * HALF + m * 16) * 16 + fq * 4);
                if (local) { const u32x4 q4 = *(const u32x4*)ps; qv[m][0] = q4.x; qv[m][1] = q4.y; qv[m][2] = q4.z; qv[m][3] = q4.w; }
                else {
#pragma unroll
                    for (int j = 0; j < 4; ++j) qv[m][j] = __hip_atomic_load(ps + j, __ATOMIC_RELAXED, __HIP_MEMORY_SCOPE_AGENT); } }
#pragma unroll
            for (int m = 0; m < 4; ++m) {
                const int row = row0 + ai * HALF + m * 16;
                float ss = 0.f;
#pragma unroll
                for (int j = 0; j < 4; ++j) ss += __builtin_bit_cast(float, qv[m][j]);
                ss += __shfl_xor(ss, 16); ss += __shfl_xor(ss, 32);
                const float rstd = 1.0f / sqrtf(ss * (1.0f / D) + EPS);
#pragma unroll
                for (int bj = 0; bj < 2; ++bj) {
                    const size_t off = (size_t)row * D + col0 + bj * HALF;
                    *(f32x4*)(OUT + off) = acc[ai][bj][m][0] * rstd * gg[bj][0]; *(f32x4*)(OUT + off + 4) = acc[ai][bj][m][1] * rstd * gg[bj][1];
                }
            }
        }
    }
};
}


#define XB_TMO      128
#define XB_XCNT(j)  (256  + 64 * (j))
#define XB_XSUB(j)  (1280 + 64 * (j))
#define XB_XGEN(j)  (2304 + 64 * (j))
#define XB_TOP      3328
#define XB_TOPGEN   3392
#define XCD_BAR_WORDS 3456
#define XB_SPIN_CAP (1u << 18)
__device__ __forceinline__ unsigned xb_ld(unsigned* p)              { return __hip_atomic_load(p, __ATOMIC_RELAXED, __HIP_MEMORY_SCOPE_AGENT); }
__device__ __forceinline__ unsigned xb_add(unsigned* p, unsigned v) { return __hip_atomic_fetch_add(p, v, __ATOMIC_RELAXED, __HIP_MEMORY_SCOPE_AGENT); }
__device__ __forceinline__ unsigned xb_xcc_id() { return (unsigned)__builtin_amdgcn_s_getreg((3 << 11) | 20) & 0xFu; }
#define XB_SPIN(cond, bar) do { unsigned _sp = 0; while (cond) { __builtin_amdgcn_s_sleep(1); \
    if ((++_sp & 255u) == 0u) { if (xb_ld(&(bar)[XB_TMO])) break; if (_sp > XB_SPIN_CAP) { atomicAdd(&(bar)[XB_TMO], 1u); break; } } } } while (0)
struct XcdBarrier { unsigned* bar; unsigned x; volatile LAS unsigned* st; };
__device__ __forceinline__ XcdBarrier xcd_barrier_post(unsigned* bar, volatile LAS unsigned* st) {
    XcdBarrier b; b.bar = bar; b.x = xb_xcc_id(); b.st = st;
    if (threadIdx.x == 0) st[2] = xb_add(&bar[XB_XCNT(b.x)], 1u);
    return b;
}
#define XL_CNT(j)   (3456 + 64 * (j))
__device__ __forceinline__ void xcc_local_barrier(const XcdBarrier& b, unsigned nloc, bool inval) {
    asm volatile("s_waitcnt vmcnt(0)" ::: "memory");
    __syncthreads();
    if (threadIdx.x == 0) {
        unsigned* bar = b.bar;
        __builtin_amdgcn_s_waitcnt(0);
        const unsigned old = xb_add(&bar[XL_CNT(b.x)], 1u), target = (old / nloc + 1u) * nloc;
        XB_SPIN(xb_ld(&bar[XL_CNT(b.x)]) < target, bar);
        if (inval) { __builtin_amdgcn_fence(__ATOMIC_ACQUIRE, "agent"); asm volatile("s_waitcnt vmcnt(0)" ::: "memory"); }
    }
    __syncthreads();
}
__device__ __forceinline__ void xcd_barrier_complete(unsigned* bar, unsigned x, unsigned& nloc, unsigned& nx) {
    const unsigned G = gridDim.x * gridDim.y * gridDim.z;
    unsigned sum, cnt, mine, sp = 0u;
    for (;;) {
        sum = 0u; cnt = 0u; mine = 0u;
#pragma unroll
        for (unsigned j = 0; j < 16; ++j) { const unsigned c = xb_ld(&bar[XB_XCNT(j)]); sum += c; cnt += (c > 0u) ? 1u : 0u; mine = (j == x) ? c : mine; }
        if (sum == G) break;
        __builtin_amdgcn_s_sleep(1);
        if ((++sp & 255u) == 0u) { if (xb_ld(&bar[XB_TMO])) break; if (sp > XB_SPIN_CAP) { atomicAdd(&bar[XB_TMO], 1u); break; } }
    }
    nloc = mine > 0u ? mine : 1u; nx = cnt > 0u ? cnt : 1u;
}
__device__ __forceinline__ void xcd_barrier(const XcdBarrier& b) {
    asm volatile("s_waitcnt vmcnt(0)" ::: "memory");
    __syncthreads();
    if (threadIdx.x == 0) {
        unsigned* bar = b.bar;
        __builtin_amdgcn_s_waitcnt(0);
        unsigned nloc = b.st[0], nx = b.st[1];
        if (nloc == 0u) { xcd_barrier_complete(bar, b.x, nloc, nx); b.st[0] = nloc; b.st[1] = nx; }
        const unsigned old = xb_add(&bar[XB_XSUB(b.x)], 1u);
        const unsigned gen = old / nloc;
        if (old + 1u == (gen + 1u) * nloc) {
            __builtin_amdgcn_fence(__ATOMIC_RELEASE, "agent");
            asm volatile("s_waitcnt vmcnt(0)" ::: "memory");
            const unsigned og = xb_add(&bar[XB_TOP], 1u);
            const unsigned tg = og / nx;
            if (og + 1u == (tg + 1u) * nx) xb_add(&bar[XB_TOPGEN], 1u);
            else XB_SPIN(xb_ld(&bar[XB_TOPGEN]) == tg, bar);
            __builtin_amdgcn_fence(__ATOMIC_ACQUIRE, "agent");
            xb_add(&bar[XB_XGEN(b.x)], 1u);
            asm volatile("s_waitcnt vmcnt(0)" ::: "memory");
        } else {
            XB_SPIN(xb_ld(&bar[XB_XGEN(b.x)]) == gen, bar);
            __builtin_amdgcn_fence(__ATOMIC_ACQUIRE, "agent");
            asm volatile("s_waitcnt vmcnt(0)" ::: "memory");
        }
    }
    __syncthreads();
}

struct Args { const float* in[23]; float* out; unsigned char* ws; int ph_lo, ph_hi; };
enum { I_X = 0, I_META, I_G1, I_WIN, I_CW, I_CB, I_LNG, I_LNB, I_LRE, I_LIM, I_LDT, I_BRE, I_BIM, I_CRE, I_CIM, I_DSK, I_GLUW, I_GLUB, I_WOUT, I_G2, I_W1, I_W2, I_GF };

__device__ __forceinline__ void transpose_item(const float* W, int K, int N, bf16_t* WT, int k0, int srcn0, int dstn0, const float* kscale, LAS float* scr, int lane) {
    f32x4 v[8];
#pragma unroll
    for (int i = 0; i < 8; ++i) { const int kk = 8 * i + (lane >> 3); v[i] = *(const f32x4*)(W + (size_t)(k0 + kk) * N + srcn0 + 4 * (lane & 7)); }
    if (kscale) {
#pragma unroll
        for (int i = 0; i < 8; ++i) v[i] = v[i] * kscale[k0 + 8 * i + (lane >> 3)];
    }
#pragma unroll
    for (int i = 0; i < 8; ++i) { LAS float* d = scr + (8 * i + (lane >> 3)) * 33 + 4 * (lane & 7); d[0] = v[i][0]; d[1] = v[i][1]; d[2] = v[i][2]; d[3] = v[i][3]; }
    asm volatile("s_waitcnt lgkmcnt(0)" ::: "memory");
    const int c = lane & 7;
#pragma unroll
    for (int j = 0; j < 4; ++j) { const int n = (lane >> 3) + 8 * j; const LAS float* s = scr + (8 * c) * 33 + n;
        u32x4 o; o.x = pk2(s[0 * 33], s[1 * 33]); o.y = pk2(s[2 * 33], s[3 * 33]); o.z = pk2(s[4 * 33], s[5 * 33]); o.w = pk2(s[6 * 33], s[7 * 33]);
        *(u32x4*)(WT + (size_t)(dstn0 + n) * K + k0 + 8 * c) = o; }
    asm volatile("s_waitcnt lgkmcnt(0)" ::: "memory");
}

__device__ __forceinline__ void phase_transposes(const Args& a, LAS unsigned char* lds, int lane, int wave, int gw, int NGW, int it0, int it1) {
    unsigned char* ws = a.ws;
    LAS float* scr = (LAS float*)(lds + wave * 16384);
    constexpr int I_IN = 16 * 48, I_GL = 8 * 16, I_OU = 16 * 32, I_1 = 16 * 128;
    for (int it = it0 + gw; it < it1; it += NGW) {
        int r = it;
        if (r < I_IN) { const int kb = r / 48, nb = r % 48, n0 = nb * 32; int src;
            if (n0 < 1024) { const int pn = n0 >> 8, rr = n0 & 255; src = rr < 128 ? pn * 128 + rr : 512 + pn * 128 + (rr - 128); } else src = n0;
            transpose_item(a.in[I_WIN], 1024, 1536, (bf16_t*)(ws + WS_WINT), kb * 64, src, n0, a.in[I_G1], scr, lane); continue; } r -= I_IN;
        if (r < I_GL) { const int kb = r / 16, nb = r % 16; transpose_item(a.in[I_GLUW], 512, 512, (bf16_t*)(ws + WS_GLUT), kb * 64, nb * 32, nb * 32, nullptr, scr, lane); continue; } r -= I_GL;
        if (r < I_OU) { const int kb = r / 32, nb = r % 32; transpose_item(a.in[I_WOUT], 1024, 1024, (bf16_t*)(ws + WS_WOUTT), kb * 64, nb * 32, nb * 32, nullptr, scr, lane); continue; } r -= I_OU;
        if (r < I_1) { const int kb = r / 128, nb = r % 128; transpose_item(a.in[I_W1], 1024, 4096, (bf16_t*)(ws + WS_W1T), kb * 64, nb * 32, nb * 32, a.in[I_G2], scr, lane); continue; } r -= I_1;
        { const int kb = r / 32, nb = r % 32; transpose_item(a.in[I_W2], 4096, 1024, (bf16_t*)(ws + WS_W2T), kb * 64, nb * 32, nb * 32, nullptr, scr, lane); }
    }
}

__device__ __forceinline__ void xb_rows(const Args& a, int lane, int m_begin, int m_end, int gwz, int NGWz) {
    unsigned char* ws = a.ws;
    bf16_t* Z1 = (bf16_t*)(ws + WS_Z1); float* RS1 = (float*)(ws + WS_SMALL + SM_RS1);
    for (int m0 = m_begin + gwz * 4; m0 < m_end; m0 += NGWz * 4) {
        if (m0 >= NTOK + 16) {
#pragma unroll
            for (int r = 0; r < 4; ++r) { u32x2* o8 = (u32x2*)(Z1 + (size_t)(m0 + r) * D) + lane;
#pragma unroll
                for (int j = 0; j < 4; ++j) o8[64 * j] = (u32x2){0u, 0u};
                if (lane == 0) RS1[m0 + r] = 0.f; }
            continue; }
        f32x4 v[4][4];
#pragma unroll
        for (int r = 0; r < 4; ++r) { const int m = m0 + r;
            const f32x4* xr = (const f32x4*)(m < NTOK ? a.in[I_X] + (size_t)m * D : a.in[I_META] + (size_t)(m - NTOK) * D) + lane;
#pragma unroll
            for (int j = 0; j < 4; ++j) v[r][j] = xr[64 * j]; }
#pragma unroll
        for (int r = 0; r < 4; ++r) { const int m = m0 + r; u32x2* o8 = (u32x2*)(Z1 + (size_t)m * D) + lane; float s = 0.f;
#pragma unroll
            for (int j = 0; j < 4; ++j) { s += (v[r][j][0] * v[r][j][0] + v[r][j][1] * v[r][j][1]) + (v[r][j][2] * v[r][j][2] + v[r][j][3] * v[r][j][3]); o8[64 * j] = (u32x2){pk2(v[r][j][0], v[r][j][1]), pk2(v[r][j][2], v[r][j][3])}; }
            const float rstd = 1.0f / sqrtf(wave_sum(s) * (1.0f / D) + EPS);
            if (lane == 0) RS1[m] = rstd; }
    }
}

__device__ __forceinline__ void phase0(const Args& a, LAS unsigned char* lds, int tid, int lane, int wave) {
    unsigned char* ws = a.ws;
    const bool split = gridDim.x >= 256;
    const int gw = split ? ((int)blockIdx.x - 128) * 8 + wave : (int)blockIdx.x * 8 + wave, NGW = split ? ((int)gridDim.x - 128) * 8 : (int)gridDim.x * 8;
#ifndef P0_PARTS
#define P0_PARTS 7
#endif
    for (int item = blockIdx.x; item < ((P0_PARTS & 1) ? 128 : 0); item += gridDim.x) {
        const int g = item >> 2, dir = (item >> 1) & 1, hh = item & 1;
        LAS f32x2* pw = (LAS f32x2*)lds;
        LAS f32x2* Bb = pw + 33 * 64;
        LAS f32x2* Cc = Bb + 64 * 16;
        LAS f32x2* cf = Cc + 16 * 64;
        const float* lre = a.in[I_LRE] + (dir * NG + g) * 64; const float* lim = a.in[I_LIM] + (dir * NG + g) * 64;
        const double dt = exp((double)a.in[I_LDT][dir * NG + g]);
        if (tid < 64) {
            const double lr = lre[tid], li = lim[tid], mg = exp(lr * dt); double sn, cs; sincos_d(li * dt, sn, cs);
            const double br = mg * cs - 1.0, bi = mg * sn, den = lr * lr + li * li;
            cf[tid] = (f32x2){(float)((br * lr + bi * li) / den), (float)((bi * lr - br * li) / den)};
        }
#pragma unroll 1
        for (int idx = tid; idx < 33 * 64; idx += 512) { const int j = idx >> 6, p = idx & 63; const double lr = lre[p], li = lim[p], an = j * li * dt;
            const float mg = expf((float)(j * lr * dt));
            const double k = rint(an * 0.15915494309189535); double r = fma(-k, 6.283185307179586, an); r = fma(-k, 2.4492935982947064e-16, r);
            const float rf = (float)r;
            pw[idx] = (f32x2){mg * cosf(rf), mg * sinf(rf)}; }
        __syncthreads();
        for (int idx = tid; idx < 1024; idx += 512) {
            const int p = idx >> 4; const f32x2 c = cf[p]; const size_t gi = (size_t)(dir * NG + g) * 1024 + idx;
            const float br = a.in[I_BRE][gi], bi = a.in[I_BIM][gi];
            Bb[idx] = (f32x2){c.x * br - c.y * bi, c.x * bi + c.y * br};
            Cc[idx] = (f32x2){a.in[I_CRE][gi], a.in[I_CIM][gi]};
        }
        __syncthreads();
        { float* KT = (float*)(ws + WS_KT); const int e = tid & 255, ho = e >> 4, hi = e & 15, d0 = hh * 16 + (tid >> 8) * 8;
          f32x2 q[64];
#pragma unroll
          for (int p = 0; p < 64; ++p) { const f32x2 c = Cc[ho * 64 + p], b = Bb[p * 16 + hi]; q[p] = (f32x2){c.x * b.x - c.y * b.y, c.x * b.y + c.y * b.x}; }
#pragma unroll 1
          for (int d = d0; d < d0 + 8; ++d) { float s0 = 0.f, s1 = 0.f;
#pragma unroll
              for (int p = 0; p < 64; p += 2) { const f32x4 w = *(const LAS f32x4*)(pw + d * 64 + p); s0 += q[p].x * w[0] - q[p].y * w[1]; s1 += q[p + 1].x * w[2] - q[p + 1].y * w[3]; }
              KT[((size_t)(g * 2 + dir) * 32 + d) * 256 + e] = s0 + s1; } }
        { bf16_t* WST = (bf16_t*)(ws + WS_WST);
#pragma unroll 1
          for (int idx = hh * 64 * 256 + tid; idx < (hh + 1) * 64 * 256; idx += 512) { const int nn = idx >> 8, kp = idx & 255, p = nn >> 1, c = nn & 1, k = 2 * kp, s = k >> 4, hi = k & 15, e = dir == 0 ? 31 - s : s;
              const f32x2 w = pw[e * 64 + p], b0 = Bb[p * 16 + hi], b1 = Bb[p * 16 + hi + 1];
              const float v0 = c ? (w.x * b0.y + w.y * b0.x) : (w.x * b0.x - w.y * b0.y), v1 = c ? (w.x * b1.y + w.y * b1.x) : (w.x * b1.x - w.y * b1.y);
              *(unsigned*)(WST + ((size_t)g * 256 + dir * 128 + nn) * 512 + k) = pk2(v0, v1); } }
        { bf16_t* BTS = (bf16_t*)(ws + WS_BTS);
#pragma unroll 1
          for (int idx = hh * 256 * 64 + tid; idx < (hh + 1) * 256 * 64; idx += 512) { const int n = idx >> 6, p = idx & 63, t = n >> 4, ho = n & 15, e = dir == 0 ? t + 1 : 32 - t;
              const f32x2 c = Cc[ho * 64 + p], w = pw[e * 64 + p];
              *(unsigned*)(BTS + ((size_t)g * 512 + n) * KS + 512 + dir * 128 + 2 * p) = pk2(c.x * w.x - c.y * w.y, -(c.x * w.y + c.y * w.x)); } }
        if (hh == 0 && tid < 64) { ((f32x2*)(ws + WS_SMALL + SM_LAMT))[(g * 2 + dir) * 64 + tid] = pw[32 * 64 + tid];
            if (dir == 0) ((f32x2*)(ws + WS_SMALL + SM_LBF))[g * 64 + tid] = pw[64 + tid]; }
        if (hh == 0 && dir == 0) for (int idx = tid; idx < 1024; idx += 512) ((f32x2*)(ws + WS_SMALL + SM_BBF))[(size_t)g * 1024 + idx] = Bb[idx];
        __syncthreads();
    }
    if ((P0_PARTS & 2) && gw >= 0) phase_transposes(a, lds, lane, wave, gw, NGW, 0, 768);
    if ((P0_PARTS & 4) && gw >= 0) xb_rows(a, lane, 0, split ? NTOK : MROWS, gw, NGW);
    if ((P0_PARTS & 4) && split && (int)blockIdx.x < 128) xb_rows(a, lane, NTOK, MROWS, (int)blockIdx.x * 8 + wave, 128 * 8);
}

__device__ __forceinline__ void phase_conv(const Args& a, LAS unsigned char* lds, int tid, int lane, int wave, int it0, int it1, int stride) {
    const bf16_t* UC = (const bf16_t*)(a.ws + WS_UC); bf16_t* MIXED = (bf16_t*)(a.ws + WS_MIXED);
    LAS unsigned char* ut = lds;
    LAS float* yt = (LAS float*)(lds + 49152);
    const int cp = tid & 255, half = tid >> 8;
    const float* cw = a.in[I_CW];
    f32x2 wk[31];
#pragma unroll
    for (int k = 0; k < 31; ++k) wk[k] = *(const f32x2*)(cw + k * DC + 2 * cp);
    const f32x2 bia = *(const f32x2*)(a.in[I_CB] + 2 * cp);
    const f32x4 lg0 = *(const f32x4*)(a.in[I_LNG] + lane * 8), lg1 = *(const f32x4*)(a.in[I_LNG] + lane * 8 + 4), lb0 = *(const f32x4*)(a.in[I_LNB] + lane * 8), lb1 = *(const f32x4*)(a.in[I_LNB] + lane * 8 + 4);
    u32x4 pf[6];
#define CONV_FETCH(item) do { const int b_ = (item) >> 8, q0_ = ((item) & 255) * 16; _Pragma("unroll") for (int e_ = 0; e_ < 6; ++e_) { const int idx = tid + e_ * 512, r = idx >> 6, cc = idx & 63, q = q0_ - 15 + r; \
        u32x4 v = (u32x4){0u, 0u, 0u, 0u}; \
        if (idx < 46 * 64) { if (q >= 0 && q < SEQ) v = *(const u32x4*)(UC + ((size_t)b_ * SEQ + q) * DC + cc * 8); else if (q < 0) v = *(const u32x4*)(UC + ((size_t)NTOK + 16 + q) * DC + cc * 8); } \
        pf[e_] = v; } } while (0)
    if (it0 < it1) CONV_FETCH(it0);
    for (int it = it0; it < it1; it += stride) {
        const int b = it >> 8, q0 = (it & 255) * 16;
#pragma unroll
        for (int e_ = 0; e_ < 6; ++e_) { const int idx = tid + e_ * 512, r = idx >> 6, cc = idx & 63; if (idx < 46 * 64) *(LAS u32x4*)(ut + r * 1024 + cc * 16) = pf[e_]; }
        __syncthreads();
        if (it + stride < it1) CONV_FETCH(it + stride);
        {
            f32x2 ac[8];
#pragma unroll
            for (int j = 0; j < 8; ++j) ac[j] = bia;
#pragma unroll
            for (int i = 0; i < 38; ++i) {
                const unsigned w = *(const LAS unsigned*)(ut + (half * 8 + i) * 1024 + cp * 4); const f32x2 uu = (f32x2){bflo(w), bfhi(w)};
#pragma unroll
                for (int j = 0; j < 8; ++j) { const int k = i - j; if (k >= 0 && k < 31) ac[j] = __builtin_elementwise_fma(wk[k], uu, ac[j]); }
            }
#pragma unroll
            for (int j = 0; j < 8; ++j) *(LAS f32x2*)(yt + (half * 8 + j) * 512 + 2 * cp) = ac[j];
        }
        __syncthreads();
        {
            const int t0 = wave * 2;
            f32x4 v[2][2]; float s1[2], s2[2];
#pragma unroll
            for (int tt = 0; tt < 2; ++tt) { v[tt][0] = *(const LAS f32x4*)(yt + (t0 + tt) * 512 + lane * 8); v[tt][1] = *(const LAS f32x4*)(yt + (t0 + tt) * 512 + lane * 8 + 4);
                const f32x4 a0 = v[tt][0], a1 = v[tt][1];
                s1[tt] = (a0[0] + a0[1]) + (a0[2] + a0[3]) + (a1[0] + a1[1]) + (a1[2] + a1[3]);
                s2[tt] = (a0[0] * a0[0] + a0[1] * a0[1]) + (a0[2] * a0[2] + a0[3] * a0[3]) + (a1[0] * a1[0] + a1[1] * a1[1]) + (a1[2] * a1[2] + a1[3] * a1[3]); }
#pragma unroll
            for (int o = 1; o < 64; o <<= 1) { const float p0 = __shfl_xor(s1[0], o), p1 = __shfl_xor(s2[0], o), p2 = __shfl_xor(s1[1], o), p3 = __shfl_xor(s2[1], o); s1[0] += p0; s2[0] += p1; s1[1] += p2; s2[1] += p3; }
#pragma unroll
            for (int tt = 0; tt < 2; ++tt) {
                const float mean = s1[tt] * (1.0f / DC), var = fmaxf(s2[tt] * (1.0f / DC) - mean * mean, 0.f), rstd = 1.0f / sqrtf(var + EPS);
                f32x4 y0 = (v[tt][0] - mean) * rstd * lg0 + lb0, y1 = (v[tt][1] - mean) * rstd * lg1 + lb1;
#pragma unroll
                for (int j = 0; j < 4; ++j) { y0[j] = y0[j] * sigmoidf_(y0[j]); y1[j] = y1[j] * sigmoidf_(y1[j]); }
                u32x4 w; w.x = cvt_pk_bf16(y0[0], y0[1]); w.y = cvt_pk_bf16(y0[2], y0[3]); w.z = cvt_pk_bf16(y1[0], y1[1]); w.w = cvt_pk_bf16(y1[2], y1[3]);
                *(u32x4*)(MIXED + ((size_t)b * SEQ + q0 + t0 + tt) * D + lane * 8) = w;
            }
        }
        __syncthreads();
    }
}

__device__ __forceinline__ void phase_toeplitz(const Args& a, int tid, int sidx, int scnt) {
    const float* KT = (const float*)(a.ws + WS_KT); bf16_t* BTS = (bf16_t*)(a.ws + WS_BTS);
    const size_t total = (size_t)NG * 512 * 64;
    for (size_t idx = (size_t)sidx * 512 + tid; idx < total; idx += (size_t)scnt * 512) {
        const int kc = (int)(idx & 63), n = (int)((idx >> 6) & 511), g = (int)(idx >> 15);
        const int t = n >> 4, ho = n & 15, k = kc * 8, s = k >> 4, hi = k & 15, d = t - s;
        f32x4 v0, v1;
        if (d > 0) { const float* p = KT + ((size_t)(g * 2 + 0) * 32 + d) * 256 + ho * 16 + hi; v0 = *(const f32x4*)p; v1 = *(const f32x4*)(p + 4); }
        else if (d < 0) { const float* p = KT + ((size_t)(g * 2 + 1) * 32 - d) * 256 + ho * 16 + hi; v0 = *(const f32x4*)p; v1 = *(const f32x4*)(p + 4); }
        else { const float* p = KT + ((size_t)(g * 2 + 0) * 32) * 256 + ho * 16 + hi; const float* q = KT + ((size_t)(g * 2 + 1) * 32) * 256 + ho * 16 + hi;
            v0 = *(const f32x4*)p + *(const f32x4*)q; v1 = *(const f32x4*)(p + 4) + *(const f32x4*)(q + 4); }
        u32x4 w; w.x = pk2(v0[0], v0[1]); w.y = pk2(v0[2], v0[3]); w.z = pk2(v1[0], v1[1]); w.w = pk2(v1[2], v1[3]);
        *(u32x4*)(BTS + ((size_t)g * 512 + n) * KS + k) = w;
    }
}

template <int DIR>
__device__ __forceinline__ void scan_run(const f32x2* __restrict__ sl, unsigned* __restrict__ dst, const f32x2 lt, float xr, float xi) {
    constexpr int BT = 8, NB = NCH / BT;
    f32x2 s0[BT], s1[BT], s2[BT];
#define SCAN_LD(dstv, bt) do { _Pragma("unroll") for (int j = 0; j < BT; ++j) { const int cc = (bt) * BT + j, c = DIR == 0 ? cc : NCH - 1 - cc; dstv[j] = sl[(size_t)c * 128]; } } while (0)
#define SCAN_RUN(srcv, bt) do { _Pragma("unroll") for (int j = 0; j < BT; ++j) { const int cc = (bt) * BT + j, c = DIR == 0 ? cc : NCH - 1 - cc; \
        dst[(size_t)c * (KS / 2)] = pk2(xr, xi); const float nr = lt[0] * xr - lt[1] * xi + srcv[j][0], ni = lt[0] * xi + lt[1] * xr + srcv[j][1]; xr = nr; xi = ni; } } while (0)
    SCAN_LD(s0, 0); SCAN_LD(s1, 1);
#pragma unroll 1
    for (int bt = 0; bt < NB; bt += 3) {
        if (bt + 2 < NB) SCAN_LD(s2, bt + 2);
        SCAN_RUN(s0, bt);
        if (bt + 1 < NB) { if (bt + 3 < NB) SCAN_LD(s0, bt + 3); SCAN_RUN(s1, bt + 1); }
        if (bt + 2 < NB) { if (bt + 4 < NB) SCAN_LD(s1, bt + 4); SCAN_RUN(s2, bt + 2); }
    }
#undef SCAN_LD
#undef SCAN_RUN
}
__device__ __forceinline__ void scan_one(const Args& a, int b, int g, int dir, int p) {
    unsigned char* ws = a.ws;
    const float* SL = (const float*)(ws + WS_SL); bf16_t* AS = (bf16_t*)(ws + WS_AS);
    const f32x2 lt = ((const f32x2*)(ws + WS_SMALL + SM_LAMT))[(g * 2 + dir) * 64 + p];
    const f32x2* sl = (const f32x2*)(SL + ((size_t)g * 512 + b * NCH) * 256 + dir * 128 + 2 * p);
    unsigned* dst = (unsigned*)(AS + ((size_t)g * 512 + b * NCH) * KS + 512 + dir * 128 + 2 * p);
    if (dir == 0) {
        float xr = 0.f, xi = 0.f;
        const f32x2 lb = ((const f32x2*)(ws + WS_SMALL + SM_LBF))[g * 64 + p];
        const f32x2* bb = (const f32x2*)(ws + WS_SMALL + SM_BBF) + (size_t)(g * 64 + p) * 16;
        const bf16_t* um = (const bf16_t*)(ws + WS_SMALL + SM_UMETA) + g * 16;
        f32x2 bv[16];
#pragma unroll
        for (int h = 0; h < 16; ++h) bv[h] = bb[h];
#pragma unroll 4
        for (int s = 0; s < 16; ++s) { float br = 0.f, bi = 0.f;
            const u32x4 u0 = *(const u32x4*)(um + s * DS), u1 = *(const u32x4*)(um + s * DS + 8);
            const float uv[16] = {bflo(u0.x), bfhi(u0.x), bflo(u0.y), bfhi(u0.y), bflo(u0.z), bfhi(u0.z), bflo(u0.w), bfhi(u0.w), bflo(u1.x), bfhi(u1.x), bflo(u1.y), bfhi(u1.y), bflo(u1.z), bfhi(u1.z), bflo(u1.w), bfhi(u1.w)};
#pragma unroll
            for (int h = 0; h < 16; ++h) { br += bv[h][0] * uv[h]; bi += bv[h][1] * uv[h]; }
            const float nr = lb[0] * xr - lb[1] * xi + br, ni = lb[0] * xi + lb[1] * xr + bi; xr = nr; xi = ni; }
        scan_run<0>(sl, dst, lt, xr, xi);
    } else scan_run<1>(sl, dst, lt, 0.f, 0.f);
}

__device__ __forceinline__ void phase_final(const Args& a, int lane, int wave) {
    const float* PS2 = (const float*)(a.ws + WS_PS2);
    f32x4 gv[4];
#pragma unroll
    for (int j = 0; j < 4; ++j) gv[j] = ((const f32x4*)a.in[I_GF])[lane + 64 * j];
    for (int m = blockIdx.x * 8 + wave; m < NTOK; m += gridDim.x * 8) {
        float ss = PS2[(size_t)m * 16 + (lane & 15)];
        ss += __shfl_xor(ss, 1); ss += __shfl_xor(ss, 2); ss += __shfl_xor(ss, 4); ss += __shfl_xor(ss, 8);
        const float rstd = 1.0f / sqrtf(ss * (1.0f / D) + EPS);
        f32x4* row = (f32x4*)(a.out + (size_t)m * D) + lane;
#pragma unroll
        for (int j = 0; j < 4; ++j) { const f32x4 v = row[64 * j]; row[64 * j] = v * rstd * gv[j]; }
    }
}

constexpr int NPHASE = 10;
template <bool COOP>
__global__ void __launch_bounds__(512, 2) fwd_kernel(Args a) {
    extern __shared__ __attribute__((aligned(16))) unsigned char lds_raw[];
    LAS unsigned char* lds = (LAS unsigned char*)lds_raw;
    const int tid = threadIdx.x, lane = tid & 63, wave = __builtin_amdgcn_readfirstlane(tid >> 6);
    unsigned char* ws = a.ws;
    const int lo = a.ph_lo, hi = a.ph_hi, G = gridDim.x; int bid = blockIdx.x; bool xloc = false;
    volatile LAS unsigned* MISC = (volatile LAS unsigned*)(lds + 131072 + 320);
    if (tid < 64) MISC[tid] = 0u;
    __syncthreads();
    XcdBarrier bar; bar.bar = (unsigned*)ws; bar.x = 0; bar.st = MISC + 8;
    if (COOP) bar = xcd_barrier_post((unsigned*)ws, MISC + 8);
#ifndef PHASE_MASK
#define PHASE_MASK 0x3ff
#endif
#define IN(k) (((PHASE_MASK >> (k)) & 1) && lo <= (k) && (k) < hi)
#define NEXTP(k) ((k) == 2 ? 5 : (k) + 1)
#ifndef REP_MASK
#define REP_MASK 0
#endif
#define RP(k) (((REP_MASK >> (k)) & 1) ? 3 : 1)
#ifndef EXTRA_SYNCS
#define EXTRA_SYNCS 0
#endif
#define REPS(k) for (int rep_ = 0; rep_ < (((REP_MASK >> (k)) & 1) ? 3 : 1); ++rep_)
#define SYNC(k) do { if (COOP && IN(k) && IN(NEXTP(k))) { xcd_barrier(bar); } } while (0)
    if (IN(0)) { phase0(a, lds, tid, lane, wave); __syncthreads(); }
    SYNC(0);
    if (COOP && lo == 0 && G == 256) {
        if (tid == 0) { unsigned ok = 1u; for (unsigned j = 0; j < 16; ++j) { const unsigned c = xb_ld(&bar.bar[XB_XCNT(j)]); if (c != (j < 8 ? 32u : 0u)) ok = 0u; } MISC[11] = ok; }
        __syncthreads();
        if (MISC[11] != 0u && bar.x < 8u && MISC[10] < 32u) { xloc = true; bid = (int)(MISC[10] * 8u + bar.x); }
    }
    if (IN(1)) {
        pg8::Gemm g{(const bf16_t*)(ws + WS_Z1), (const bf16_t*)(ws + WS_WINT), D, D, D, 0, 0};
        pg8::Order S; S.init(MROWS / 256, 1536 / 256, 1, G, bid, RP(1));
        pg8::EpiIn E{(bf16_t*)(ws + WS_UC), (bf16_t*)(ws + WS_AS), (bf16_t*)(ws + WS_SMALL + SM_UMETA), (const float*)(ws + WS_SMALL + SM_RS1)};
        pg8::gemm_phase<pg8::EpiIn>(lds, g, S, E);
        const int n2 = S.nwg - (S.nwg / G) * G;
        if (n2 == 0 || bid >= n2) { const int sidx = n2 == 0 ? bid : bid - n2, scnt = n2 == 0 ? G : G - n2;
            phase_toeplitz(a, tid, sidx, scnt);
            phase_transposes(a, lds, lane, wave, sidx * 8 + wave, scnt * 8, 768, 5504); }
    }
    SYNC(1);
    if (IN(2)) {
        unsigned* flags = (unsigned*)(ws + 49152);
        if (bid < 128) {
            const int xcd = bid & 7, j = bid >> 3, gg = xcd * 4 + (j >> 2), pm = (j >> 1) & 1, pn = j & 1;
            __syncthreads();
            if (bid < 64) phase_conv(a, lds, tid, lane, wave, bid, 192, 64); else phase_conv(a, lds, tid, lane, wave, 192 + (bid - 64), 320, 64);
            __syncthreads();
            pg8::Gemm g{(const bf16_t*)(ws + WS_AS), (const bf16_t*)(ws + WS_BTS), KS, KS, KS, (size_t)512 * KS, (size_t)512 * KS};
            pg8::OneUnit S{{pm, pn, gg}, flags + 64 * (gg * 2 + pm), 6, xloc}; pg8::EpiSsm E{(const bf16_t*)(ws + WS_AS), a.in[I_DSK], (bf16_t*)(ws + WS_YG)};
            pg8::gemm_phase<pg8::EpiSsm, pg8::OneUnit>(lds, g, S, E);
        } else if (bid < 192) {
            const int xcd = bid & 7, j = (bid - 128) >> 3, gg = xcd * 4 + (j >> 1), pm = j & 1;
            __syncthreads();
            { pg8::Gemm g{(const bf16_t*)(ws + WS_AS), (const bf16_t*)(ws + WS_WST), KS, 512, 512, (size_t)512 * KS, (size_t)256 * 512};
              pg8::OneUnit S{{pm, 0, gg}, nullptr, -1, false}; pg8::EpiSL E{(float*)(ws + WS_SL)};
              pg8::gemm_phase<pg8::EpiSL, pg8::OneUnit>(lds, g, S, E); }
            asm volatile("s_waitcnt vmcnt(0)" ::: "memory"); __syncthreads();
            if (tid < 256) scan_one(a, 2 * pm + (tid >> 7), gg, (tid >> 6) & 1, tid & 63);
            asm volatile("s_waitcnt vmcnt(0)" ::: "memory"); __syncthreads();
            if (tid == 0) { if (!xloc) { __builtin_amdgcn_fence(__ATOMIC_RELEASE, "agent"); asm volatile("s_waitcnt vmcnt(0)" ::: "memory"); }
                __hip_atomic_store(flags + 64 * (gg * 2 + pm), 1u, __ATOMIC_RELAXED, __HIP_MEMORY_SCOPE_AGENT); }
            phase_conv(a, lds, tid, lane, wave, 320 + (bid - 128), 512, 64);
        } else {
            __syncthreads();
            phase_conv(a, lds, tid, lane, wave, 512 + (bid - 192), 1024, 64);
        }
    }
    SYNC(2);
    if (IN(5)) {
        __syncthreads();
        pg8::Gemm g{(const bf16_t*)(ws + WS_YG), (const bf16_t*)(ws + WS_GLUT), DS, DS, DS, 0, 0};
        pg8::Order S; S.init(NTOK / 256, 2, 1, G, bid, RP(5));
        pg8::EpiGlu E{(const bf16_t*)(ws + WS_YG), a.in[I_GLUB], (bf16_t*)(ws + WS_MIXED)};
        pg8::gemm_phase<pg8::EpiGlu>(lds, g, S, E);
    }
    if (xloc) xcc_local_barrier(bar, 32u, false); else SYNC(5);
    if (IN(6)) {
        __syncthreads();
        pg8::Gemm g{(const bf16_t*)(ws + WS_MIXED), (const bf16_t*)(ws + WS_WOUTT), D, D, D, 0, 0};
        pg8::Order S; S.init(NTOK / 256, 4, 1, G, bid, RP(6));
        pg8::EpiOut E{(const bf16_t*)(ws + WS_Z1), (bf16_t*)(ws + WS_H2B), (float*)(ws + WS_PS)};
        pg8::gemm_phase<pg8::EpiOut>(lds, g, S, E);
        if (tid == 0) __hip_atomic_fetch_add((unsigned*)(ws + 65536), 1u, __ATOMIC_RELAXED, __HIP_MEMORY_SCOPE_AGENT);
    }
    if (xloc) xcc_local_barrier(bar, 32u, false); else SYNC(6);
    if (IN(7)) {
        pg8::Gemm g{(const bf16_t*)(ws + WS_H2B), (const bf16_t*)(ws + WS_W1T), D, D, D, 0, 0};
        pg8::Order S; S.init(NTOK / 256, DFF / 256, 1, G, bid, RP(7));
        pg8::EpiFF1 E{(const float*)(ws + WS_PS), (bf16_t*)(ws + WS_HID), (const unsigned*)(ws + 65536), (unsigned)G, MISC + 17};
        pg8::gemm_phase<pg8::EpiFF1>(lds, g, S, E);
    }
    if (xloc) xcc_local_barrier(bar, 32u, true); else SYNC(7);
    if (IN(8)) {
        pg8::Gemm g{(const bf16_t*)(ws + WS_HID), (const bf16_t*)(ws + WS_W2T), DFF, DFF, DFF, 0, 0};
        pg8::Order S; S.init(NTOK / 256, 4, 1, G, bid);
        pg8::EpiFinal E{a.out, (const bf16_t*)(ws + WS_H2B), (float*)(ws + WS_PS2), (unsigned*)(ws + 32768), a.in[I_GF], (const float*)(ws + WS_PS), xloc};
        pg8::gemm_phase<pg8::EpiFinal>(lds, g, S, E);
    }

#undef IN
#undef SYNC
}

extern "C" void kernel_launch(void* const* d_in, const int* in_sizes, int n_in, void* d_out, int out_size, void* d_ws, size_t ws_size, hipStream_t stream) {
    static int grid = 0;
    if (grid == 0) {
        if (n_in != 23 || out_size != NTOK * D || ws_size < WS_END) { fprintf(stderr, "kernel_launch: unexpected problem (n_in %d out %d ws %zu)\n", n_in, out_size, ws_size); grid = -1; return; }
        int dev = 0, cus = 0, per_cu = 0;
        hipGetDevice(&dev); hipDeviceGetAttribute(&cus, hipDeviceAttributeMultiprocessorCount, dev);
        hipFuncSetAttribute((const void*)fwd_kernel<true>, hipFuncAttributeMaxDynamicSharedMemorySize, LDS_BYTES);
        hipFuncSetAttribute((const void*)fwd_kernel<false>, hipFuncAttributeMaxDynamicSharedMemorySize, LDS_BYTES);
        hipOccupancyMaxActiveBlocksPerMultiprocessor(&per_cu, (const void*)fwd_kernel<true>, 512, LDS_BYTES);
        if (per_cu < 1) { fprintf(stderr, "kernel_launch: the occupancy query reports %d workgroups per CU for this kernel + %d B of LDS: a resident grid is impossible, nothing launched\n", per_cu, LDS_BYTES); grid = -1; return; }
        (void)hipGetLastError();
        grid = cus;
        if (grid < 256) { fprintf(stderr, "kernel_launch: this kernel's phase program needs >= 256 CUs (got %d)\n", cus); grid = -1; return; }
    }
    if (grid < 0) return;
    Args a{};
    for (int i = 0; i < 23; ++i) a.in[i] = (const float*)d_in[i];
    a.out = (float*)d_out; a.ws = (unsigned char*)d_ws;
#if MK_MULTI
    for (int p = 0; p < NPHASE; ++p) { a.ph_lo = p; a.ph_hi = p + 1; hipLaunchKernelGGL(fwd_kernel<false>, dim3(grid), dim3(512), LDS_BYTES, stream, a); }
#else
    a.ph_lo = 0; a.ph_hi = NPHASE;
    if (hipMemsetAsync(d_ws, 0, 131072, stream) != hipSuccess) { fprintf(stderr, "kernel_launch: memset of barrier words failed\n"); return; }
    void* args[] = {&a};
    hipError_t e = hipLaunchCooperativeKernel((const void*)fwd_kernel<true>, dim3(grid), dim3(512), args, LDS_BYTES, stream);
    if (e != hipSuccess) fprintf(stderr, "cooperative launch failed: %s (grid %d)\n", hipGetErrorString(e), grid);
#endif
}
```

```cpp
#include <hip/hip_runtime.h>
#include <hip/hip_cooperative_groups.h>
#include <cstdio>
#include <cstdint>
namespace cg = cooperative_groups;

#define LAS __attribute__((address_space(3)))
typedef unsigned short bf16_t;
typedef short bf16x8 __attribute__((ext_vector_type(8)));
typedef float f32x4 __attribute__((ext_vector_type(4)));
typedef float f32x2 __attribute__((ext_vector_type(2)));
typedef unsigned u32x4 __attribute__((ext_vector_type(4)));
typedef unsigned u32x2 __attribute__((ext_vector_type(2)));

#ifndef MK_MULTI
#define MK_MULTI 0
#endif

constexpr int D = 1024, NTOK = 16384, SEQ = 4096, MROWS = 16640  ;
constexpr int DC = 512, DS = 512, NG = 32, TCH = 32, NCH = 128  , KS = 768  ;
constexpr int DFF = 4096;
constexpr float EPS = 1e-5f;
constexpr size_t MiB = 1u << 20;
constexpr size_t WS_W1T = 1 * MiB, WS_W2T = 9 * MiB, WS_WOUTT = 17 * MiB, WS_WINT = 19 * MiB, WS_GLUT = 22 * MiB, WS_PS = 23 * MiB, WS_PS2 = 24 * MiB,
                 WS_SMALL = 25 * MiB, WS_KT = 26 * MiB, WS_H2B = 28 * MiB, WS_HID = 60 * MiB, WS_Z1 = 60 * MiB, WS_UC = 93 * MiB, WS_AS = 110 * MiB,
                 WS_BTS = 134 * MiB, WS_SL = 158 * MiB, WS_WST = 174 * MiB, WS_MIXED = 188 * MiB, WS_YG = 220 * MiB, WS_END = 236 * MiB;
constexpr size_t SM_UMETA = 0  , SM_LBF = 32768  , SM_LAMT = 65536  , SM_BBF = 131072  , SM_RS1 = 524288  ;

constexpr int LDS_BYTES = 147456;

__device__ __forceinline__ unsigned f2bf(float f) { unsigned u = __builtin_bit_cast(unsigned, f); return (u + 0x7fffu + ((u >> 16) & 1u)) >> 16; }
__device__ __forceinline__ unsigned pk2(float lo, float hi) { return f2bf(lo) | (f2bf(hi) << 16); }
__device__ __forceinline__ unsigned cvt_pk_bf16(float lo, float hi) { unsigned r; asm volatile("v_cvt_pk_bf16_f32 %0, %1, %2" : "=v"(r) : "v"(lo), "v"(hi)); return r; }
__device__ __forceinline__ float bflo(unsigned w) { return __builtin_bit_cast(float, w << 16); }
__device__ __forceinline__ float bfhi(unsigned w) { return __builtin_bit_cast(float, w & 0xffff0000u); }
__device__ __forceinline__ float wave_sum(float v) {
#pragma unroll
    for (int o = 1; o < 64; o <<= 1) v += __shfl_xor(v, o);
    return v;
}
__device__ __forceinline__ float sigmoidf_(float x) { return __builtin_amdgcn_rcpf(1.0f + __expf(-x)); }
__device__ __forceinline__ f32x2 sigmoid_pk(f32x2 a) { const f32x2 t = a * (-1.4426950409f); f32x2 e; e.x = __builtin_amdgcn_exp2f(t.x); e.y = __builtin_amdgcn_exp2f(t.y);
    const f32x2 d = e + 1.0f; f32x2 r; r.x = __builtin_amdgcn_rcpf(d.x); r.y = __builtin_amdgcn_rcpf(d.y); return r; }
__device__ __forceinline__ f32x2 gelu_tanh_pk(f32x2 v) { const f32x2 t = v * ((v * v) * (-0.1029432f) + (-2.3022082f)); f32x2 e; e.x = __builtin_amdgcn_exp2f(t.x); e.y = __builtin_amdgcn_exp2f(t.y);
    const f32x2 d = e + 1.0f; f32x2 r; r.x = __builtin_amdgcn_rcpf(d.x); r.y = __builtin_amdgcn_rcpf(d.y); return v * r; }
__device__ __forceinline__ float gelu_tanh(float x) { const float u = 1.5957691216f * (x + 0.044715f * x * x * x); return x * sigmoidf_(u); }

__device__ __forceinline__ void sincos_d(double a, double& s, double& c) {
    const double k = rint(a * 0.15915494309189535); double r = fma(-k, 6.283185307179586, a); r = fma(-k, 2.4492935982947064e-16, r);
    const double q = r * 0.25, q2 = q * q;
    double sq = q * (1.0 + q2 * (-1.0 / 6 + q2 * (1.0 / 120 + q2 * (-1.0 / 5040 + q2 * (1.0 / 362880 + q2 * (-1.0 / 39916800 + q2 * (1.0 / 6227020800.0)))))));
    double cq = 1.0 + q2 * (-0.5 + q2 * (1.0 / 24 + q2 * (-1.0 / 720 + q2 * (1.0 / 40320 + q2 * (-1.0 / 3628800 + q2 * (1.0 / 479001600.0 + q2 * (-1.0 / 87178291200.0)))))));
    const double s2 = 2.0 * sq * cq, c2 = 1.0 - 2.0 * sq * sq;
    s = 2.0 * s2 * c2; c = 1.0 - 2.0 * s2 * s2;
}

namespace pg8 {
constexpr int BM = 256, BK = 64, HALF = 128, HTB = HALF * BK * 2, STAGE_BYTES = 8 * HTB, NXCD = 8, WGM = 8;
__device__ __forceinline__ int lds_byte(int r, int c) { const int st = (r >> 4) * 2 + (c >> 5), rr = r & 15, cc = c & 31, ob = rr * 64 + cc * 2; return st * 1024 + (ob ^ (((ob >> 9) & 1) << 5)); }
__device__ __forceinline__ void stage_rc(int b, int& R, int& C) { const int st = b / 1024, sb = b % 1024, swz = sb ^ (((sb >> 9) & 1) << 5); R = (st >> 1) * 16 + swz / 64; C = (st & 1) * 32 + (swz % 64) / 2; }
__device__ __forceinline__ int perm32(int rho) { const int n = rho >> 4, i = rho & 15; return 8 * (i >> 2) + 4 * n + (i & 3); }

struct Unit { int pm, pn, g; };
struct Gemm { const bf16_t* A; const bf16_t* Bt; int lda, ldb, K; size_t gsA, gsB; };

struct Order {
    static constexpr bool HASWAIT = false;
    __device__ __forceinline__ void kwait(int) const {}
    int nM, nN, nG, nwg, G, c, rep;
    __device__ void init(int nM_, int nN_, int nG_, int G_, int c_, int rep_ = 1) { nM = nM_; nN = nN_; nG = nG_; nwg = nM * nN * nG; G = G_; c = c_; rep = rep_; }
    __device__ bool next(int i, Unit& u) const {
        long L = (long)i * G + c; if (L >= (long)nwg * rep) return false; L %= nwg;
        if (nG == 1) {
            int wgid = (int)L; { const int q = nwg / NXCD, r = nwg % NXCD, xcd = wgid % NXCD, off = wgid / NXCD; wgid = (xcd < r ? xcd * (q + 1) : r * (q + 1) + (xcd - r) * q) + off; }
            const int nig = WGM * nN, gid = wgid / nig, fm = gid * WGM, gsz = (nM - fm) < WGM ? (nM - fm) : WGM;
            u.pm = fm + ((wgid % nig) % gsz); u.pn = (wgid % nig) / gsz; u.g = 0;
        } else {
            const int per = nM * nN, l = (int)L; u.g = l / per; const int r = l % per; u.pm = r % nM; u.pn = r / nM;
        }
        return true;
    }
};

struct OneUnit {
    static constexpr bool HASWAIT = true;
    Unit u; const unsigned* flag; int wait_t; bool samexcc;
    __device__ __forceinline__ bool next(int i, Unit& o) const { if (i > 0) return false; o = u; return true; }
    __device__ __forceinline__ void kwait(int t) const {
        if (flag == nullptr || t != wait_t) return;
        unsigned spins = 0;
        while ((unsigned)__builtin_amdgcn_readfirstlane(__hip_atomic_load(flag, __ATOMIC_RELAXED, __HIP_MEMORY_SCOPE_AGENT)) == 0u) { __builtin_amdgcn_s_sleep(2); if (++spins > (1u << 22)) break; }
        if (!samexcc) { __builtin_amdgcn_fence(__ATOMIC_ACQUIRE, "agent"); asm volatile("s_waitcnt vmcnt(0)" ::: "memory"); }
        else asm volatile("" ::: "memory");
    }
};

template <class Epi, class Sched = Order, bool ALIGN_EPI = true>
__device__ __forceinline__ void gemm_phase(LAS unsigned char* lds, const Gemm g, const Sched& S, const Epi& E) {
    const int tid = threadIdx.x, wid = __builtin_amdgcn_readfirstlane(tid >> 6), lane = tid & 63, wr = wid >> 2, wc = wid & 3, fr = lane & 15, fq = lane >> 4;
    const int K = g.K, nt = K / BK;
    unsigned voffA[2], voffB[2];
#pragma unroll
    for (int i = 0; i < 2; ++i) { int R, C; stage_rc(tid * 16 + i * 8192, R, C); const int Rb = Epi::PERM ? ((R & ~31) + perm32(R & 31)) : R;
        voffA[i] = (unsigned)(R * g.lda + C) * 2u; voffB[i] = (unsigned)(Rb * g.ldb + C) * 2u; }
    const size_t kstep = (size_t)(BK * 2);
    const size_t hstepA = (size_t)HALF * g.lda * 2, hstepB = (size_t)HALF * g.ldb * 2;
    const unsigned ldsw = (unsigned)wid * 1024u;
    const int aoff = lds_byte(wr * 64 + fr, fq * 8), boff = lds_byte(wc * 32 + fr, fq * 8);
#define PG8_SA(b, h) (((b) * 2 + (h)) * HTB)
#define PG8_SB(b, h) ((4 + (b) * 2 + (h)) * HTB)
#define PG8_STAGE(bufoff, gbase, voff) do { _Pragma("unroll") for (int _i = 0; _i < 2; ++_i) \
        __builtin_amdgcn_global_load_lds((const unsigned*)((const char*)(gbase) + (voff)[_i]), (LAS unsigned*)(lds + (bufoff) + ldsw + _i * 8192), 16, 0, 0); } while (0)
#define PG8_LDA(dst, b, h) do { _Pragma("unroll") for (int m = 0; m < 4; ++m) _Pragma("unroll") for (int k = 0; k < 2; ++k) dst[m][k] = *(const LAS bf16x8*)(lds + PG8_SA(b, h) + aoff + m * 2048 + k * 1024); } while (0)
#define PG8_LDB(dst, b, h) do { _Pragma("unroll") for (int n = 0; n < 2; ++n) _Pragma("unroll") for (int k = 0; k < 2; ++k) dst[n][k] = *(const LAS bf16x8*)(lds + PG8_SB(b, h) + boff + n * 2048 + k * 1024); } while (0)
#define PG8_MMA(ai, bj, At, Bt) do { __builtin_amdgcn_s_setprio(1); _Pragma("unroll") for (int m = 0; m < 4; ++m) _Pragma("unroll") for (int n = 0; n < 2; ++n) _Pragma("unroll") for (int k = 0; k < 2; ++k) \
        acc[ai][bj][m][n] = __builtin_amdgcn_mfma_f32_16x16x32_bf16(Bt[n][k], At[m][k], acc[ai][bj][m][n], 0, 0, 0); __builtin_amdgcn_s_setprio(0); } while (0)
#define PG8_WAIT_V(n) asm volatile("s_waitcnt vmcnt(" #n ")" ::: "memory")
#define PG8_WAIT_L(n) asm volatile("s_waitcnt lgkmcnt(" #n ")" ::: "memory")
#define PG8_BAR __builtin_amdgcn_s_barrier()
#define PG8_SCHED __builtin_amdgcn_sched_barrier(0)
    Unit cur, nxt; int ui = 0;
    if (!S.next(0, cur)) return;
    f32x4 acc[2][2][4][2];
#pragma unroll
    for (int a = 0; a < 2; ++a)
#pragma unroll
        for (int b = 0; b < 2; ++b)
#pragma unroll
            for (int m = 0; m < 4; ++m)
#pragma unroll
                for (int n = 0; n < 2; ++n) acc[a][b][m][n] = (f32x4){0.f, 0.f, 0.f, 0.f};
    bf16x8 At[4][2], B0[2][2], B1[2][2];
    const char* cA = (const char*)(g.A + (size_t)cur.g * g.gsA + (size_t)cur.pm * BM * g.lda);
    const char* cB = (const char*)(g.Bt + (size_t)cur.g * g.gsB + (size_t)cur.pn * BM * g.ldb);
    PG8_STAGE(PG8_SB(0, 0), cB, voffB); PG8_STAGE(PG8_SB(0, 1), cB + hstepB, voffB); PG8_STAGE(PG8_SA(0, 0), cA, voffA); PG8_STAGE(PG8_SA(0, 1), cA + hstepA, voffA);
    if (wr == 1) PG8_BAR;
    PG8_WAIT_V(2); PG8_BAR;
    PG8_STAGE(PG8_SB(1, 0), cB + kstep, voffB); PG8_STAGE(PG8_SA(1, 0), cA + kstep, voffA); PG8_STAGE(PG8_SB(1, 1), cB + hstepB + kstep, voffB);
    PG8_WAIT_V(6); PG8_BAR;
    for (;;) {
        const bool has_next = S.next(ui + 1, nxt);
        const char* nA = has_next ? (const char*)(g.A + (size_t)nxt.g * g.gsA + (size_t)nxt.pm * BM * g.lda) : cA;
        const char* nB = has_next ? (const char*)(g.Bt + (size_t)nxt.g * g.gsB + (size_t)nxt.pn * BM * g.ldb) : cB;
        for (int t = 0; t < nt; t += 2) {
            if constexpr (Sched::HASWAIT) S.kwait(t);
            const bool last = (t == nt - 2);
            const char* a1 = cA + (size_t)(t + 1) * kstep;
            const char* a2 = last ? nA : cA + (size_t)(t + 2) * kstep; const char* b2 = last ? nB : cB + (size_t)(t + 2) * kstep;
            const char* a3 = a2 + kstep; const char* b3 = b2 + kstep;
            PG8_LDB(B0, 0, 0); PG8_LDB(B1, 0, 1); PG8_SCHED; PG8_LDA(At, 0, 0); PG8_STAGE(PG8_SA(1, 1), a1 + hstepA, voffA);
            PG8_WAIT_V(8); PG8_WAIT_L(0); PG8_BAR; PG8_MMA(0, 0, At, B0); PG8_MMA(0, 1, At, B1); PG8_BAR; PG8_SCHED;
            PG8_LDA(At, 0, 1); PG8_STAGE(PG8_SB(0, 0), b2, voffB); PG8_STAGE(PG8_SB(0, 1), b2 + hstepB, voffB); PG8_STAGE(PG8_SA(0, 0), a2, voffA);
            PG8_WAIT_V(8); PG8_WAIT_L(0); PG8_BAR; PG8_MMA(1, 0, At, B0); PG8_MMA(1, 1, At, B1); PG8_BAR; PG8_SCHED;
            PG8_LDB(B0, 1, 0); PG8_LDB(B1, 1, 1); PG8_SCHED; PG8_LDA(At, 1, 0); PG8_STAGE(PG8_SA(0, 1), a2 + hstepA, voffA);
            PG8_WAIT_V(8); PG8_WAIT_L(0); PG8_BAR; PG8_MMA(0, 0, At, B0); PG8_MMA(0, 1, At, B1); PG8_BAR; PG8_SCHED;
            PG8_LDA(At, 1, 1); PG8_STAGE(PG8_SB(1, 0), b3, voffB); PG8_STAGE(PG8_SB(1, 1), b3 + hstepB, voffB); PG8_STAGE(PG8_SA(1, 0), a3, voffA);
            PG8_WAIT_V(8); PG8_WAIT_L(0); PG8_BAR; PG8_MMA(1, 0, At, B0); PG8_MMA(1, 1, At, B1); PG8_BAR; PG8_SCHED;
        }
        if constexpr (ALIGN_EPI) { if (wr == 0) PG8_BAR; }
        E(acc, cur, wr, wc, fr, fq);
        if (!has_next) break;
#pragma unroll
        for (int a = 0; a < 2; ++a)
#pragma unroll
            for (int b = 0; b < 2; ++b)
#pragma unroll
                for (int m = 0; m < 4; ++m)
#pragma unroll
                    for (int n = 0; n < 2; ++n) acc[a][b][m][n] = (f32x4){0.f, 0.f, 0.f, 0.f};
        cur = nxt; cA = nA; cB = nB; ++ui;
        if constexpr (ALIGN_EPI) { if (wr == 1) PG8_BAR; }
    }
    PG8_WAIT_V(0);
    if constexpr (!ALIGN_EPI) { if (wr == 0) PG8_BAR; }
    PG8_BAR;
#undef PG8_SA
#undef PG8_SB
#undef PG8_STAGE
#undef PG8_LDA
#undef PG8_LDB
#undef PG8_MMA
#undef PG8_WAIT_V
#undef PG8_WAIT_L
#undef PG8_BAR
#undef PG8_SCHED
}

typedef f32x4 Acc[2][2][4][2];

struct EpiIn {
    static constexpr bool PERM = true;
    bf16_t* UC; bf16_t* AS; bf16_t* UMETA; const float* RS1;
    __device__ __forceinline__ void operator()(const Acc& acc, const Unit& u, int wr, int wc, int fr, int fq) const {
        const int row0 = u.pm * BM + wr * 64 + fr;
        float rsv[2][4];
#pragma unroll
        for (int ai = 0; ai < 2; ++ai)
#pragma unroll
            for (int m = 0; m < 4; ++m) rsv[ai][m] = RS1[row0 + ai * HALF + m * 16];
        if (u.pn < 4) {
            const int ch0 = u.pn * 128 + wc * 32 + 8 * fq;
#pragma unroll
            for (int ai = 0; ai < 2; ++ai)
#pragma unroll
                for (int m = 0; m < 4; ++m) {
                    const int row = row0 + ai * HALF + m * 16;
                    const float rs = rsv[ai][m];
                    const f32x4 v0 = acc[ai][0][m][0] * rs, v1 = acc[ai][0][m][1] * rs, g0 = acc[ai][1][m][0] * rs, g1 = acc[ai][1][m][1] * rs;
                    u32x4 w;
                    const f32x2 s0 = sigmoid_pk((f32x2){g0[0], g0[1]}), s1 = sigmoid_pk((f32x2){g0[2], g0[3]}), s2 = sigmoid_pk((f32x2){g1[0], g1[1]}), s3 = sigmoid_pk((f32x2){g1[2], g1[3]});
                    w.x = cvt_pk_bf16(v0[0] * s0.x, v0[1] * s0.y); w.y = cvt_pk_bf16(v0[2] * s1.x, v0[3] * s1.y);
                    w.z = cvt_pk_bf16(v1[0] * s2.x, v1[1] * s2.y); w.w = cvt_pk_bf16(v1[2] * s3.x, v1[3] * s3.y);
                    *(u32x4*)(UC + (size_t)row * DC + ch0) = w;
                }
        } else {
#pragma unroll
            for (int bj = 0; bj < 2; ++bj) {
                const int c0 = (u.pn - 4) * 256 + bj * HALF + wc * 32 + 8 * fq, gg = c0 >> 4, hi0 = c0 & 15;
#pragma unroll
                for (int ai = 0; ai < 2; ++ai)
#pragma unroll
                    for (int m = 0; m < 4; ++m) {
                        const int row = row0 + ai * HALF + m * 16;
                        const float rs = rsv[ai][m];
                        const f32x4 v0 = acc[ai][bj][m][0] * rs, v1 = acc[ai][bj][m][1] * rs;
                        u32x4 w; w.x = cvt_pk_bf16(v0[0], v0[1]); w.y = cvt_pk_bf16(v0[2], v0[3]); w.z = cvt_pk_bf16(v1[0], v1[1]); w.w = cvt_pk_bf16(v1[2], v1[3]);
                        if (row < NTOK) { const int b = row >> 12, pos = row & 4095, ch = pos >> 5, s = pos & 31;
                            *(u32x4*)(AS + ((size_t)gg * 512 + b * NCH + ch) * KS + s * 16 + hi0) = w; }
                        else if (row < NTOK + 16) *(u32x4*)(UMETA + (size_t)(row - NTOK) * DS + c0) = w;
                    }
            }
        }
    }
};
struct EpiSL {
    static constexpr bool PERM = false;
    float* SL;
    __device__ __forceinline__ void operator()(const Acc& acc, const Unit& u, int wr, int wc, int fr, int fq) const {
        const int row0 = u.pm * BM + wr * 64 + fr, col0 = wc * 32 + 4 * fq;
#pragma unroll
        for (int ai = 0; ai < 2; ++ai)
#pragma unroll
            for (int m = 0; m < 4; ++m) { float* rowp = SL + ((size_t)u.g * 512 + row0 + ai * HALF + m * 16) * 256 + col0;
#pragma unroll
                for (int bj = 0; bj < 2; ++bj)
#pragma unroll
                    for (int n = 0; n < 2; ++n) *(f32x4*)(rowp + bj * HALF + n * 16) = acc[ai][bj][m][n]; }
    }
};
struct EpiSsm {
    static constexpr bool PERM = true;
    const bf16_t* AS; const float* Dsk; bf16_t* YG;
    __device__ __forceinline__ void operator()(const Acc& acc, const Unit& u, int wr, int wc, int fr, int fq) const {
        const int row0 = u.pm * BM + wr * 64 + fr, ho0 = (8 * fq) & 15;
        const f32x4 d0 = *(const f32x4*)(Dsk + u.g * 16 + ho0), d1 = *(const f32x4*)(Dsk + u.g * 16 + ho0 + 4);
#pragma unroll
        for (int ai = 0; ai < 2; ++ai) {
            u32x4 uv[1 + 0 * 2][4][2];
#pragma unroll
            for (int m = 0; m < 4; ++m)
#pragma unroll
                for (int bj = 0; bj < 2; ++bj) uv[0][m][bj] = *(const u32x4*)(AS + ((size_t)u.g * 512 + row0 + ai * HALF + m * 16) * KS + u.pn * BM + bj * HALF + wc * 32 + 8 * fq);
#pragma unroll
            for (int m = 0; m < 4; ++m) {
                const int r = row0 + ai * HALF + m * 16;
                const size_t tok0 = (size_t)(r >> 7) * SEQ + (size_t)(r & 127) * TCH;
#pragma unroll
                for (int bj = 0; bj < 2; ++bj) {
                    const int c = u.pn * BM + bj * HALF + wc * 32 + 8 * fq, t = c >> 4;
                    const u32x4 uu = uv[0][m][bj];
                    const f32x4 a0 = acc[ai][bj][m][0], a1 = acc[ai][bj][m][1];
                    float y[8];
                    y[0] = a0[0] + d0[0] * bflo(uu.x); y[1] = a0[1] + d0[1] * bfhi(uu.x); y[2] = a0[2] + d0[2] * bflo(uu.y); y[3] = a0[3] + d0[3] * bfhi(uu.y);
                    y[4] = a1[0] + d1[0] * bflo(uu.z); y[5] = a1[1] + d1[1] * bfhi(uu.z); y[6] = a1[2] + d1[2] * bflo(uu.w); y[7] = a1[3] + d1[3] * bfhi(uu.w);
#pragma unroll
                    for (int j = 0; j < 8; j += 2) { const f32x2 gq = gelu_tanh_pk((f32x2){y[j], y[j + 1]}); y[j] = gq.x; y[j + 1] = gq.y; }
                    u32x4 w; w.x = cvt_pk_bf16(y[0], y[1]); w.y = cvt_pk_bf16(y[2], y[3]); w.z = cvt_pk_bf16(y[4], y[5]); w.w = cvt_pk_bf16(y[6], y[7]);
                    *(u32x4*)(YG + (tok0 + t) * DS + u.g * 16 + ho0) = w;
                }
            }
        }
    }
};
struct EpiGlu {
    static constexpr bool PERM = true;
    const bf16_t* YG; const float* bias; bf16_t* MIXED;
    __device__ __forceinline__ void operator()(const Acc& acc, const Unit& u, int wr, int wc, int fr, int fq) const {
        const int row0 = u.pm * BM + wr * 64 + fr;
        f32x4 bv[2][2];
#pragma unroll
        for (int bj = 0; bj < 2; ++bj) { const int c = u.pn * BM + bj * HALF + wc * 32 + 8 * fq; bv[bj][0] = *(const f32x4*)(bias + c); bv[bj][1] = *(const f32x4*)(bias + c + 4); }
#pragma unroll
        for (int ai = 0; ai < 2; ++ai) {
            u32x4 yv[2][4];
#pragma unroll
            for (int bj = 0; bj < 2; ++bj)
#pragma unroll
                for (int m = 0; m < 4; ++m) yv[bj][m] = *(const u32x4*)(YG + (size_t)(row0 + ai * HALF + m * 16) * DS + u.pn * BM + bj * HALF + wc * 32 + 8 * fq);
#pragma unroll
            for (int bj = 0; bj < 2; ++bj) {
                const int c = u.pn * BM + bj * HALF + wc * 32 + 8 * fq;
                const f32x4 b0 = bv[bj][0], b1 = bv[bj][1];
#pragma unroll
                for (int m = 0; m < 4; ++m) {
                    const int row = row0 + ai * HALF + m * 16;
                    const u32x4 yy = yv[bj][m];
                    const f32x4 a0 = acc[ai][bj][m][0] + b0, a1 = acc[ai][bj][m][1] + b1;
                    u32x4 w;
                    const f32x2 s0 = sigmoid_pk((f32x2){a0[0], a0[1]}), s1 = sigmoid_pk((f32x2){a0[2], a0[3]}), s2 = sigmoid_pk((f32x2){a1[0], a1[1]}), s3 = sigmoid_pk((f32x2){a1[2], a1[3]});
                    w.x = cvt_pk_bf16(bflo(yy.x) * s0.x, bfhi(yy.x) * s0.y); w.y = cvt_pk_bf16(bflo(yy.y) * s1.x, bfhi(yy.y) * s1.y);
                    w.z = cvt_pk_bf16(bflo(yy.z) * s2.x, bfhi(yy.z) * s2.y); w.w = cvt_pk_bf16(bflo(yy.w) * s3.x, bfhi(yy.w) * s3.y);
                    *(u32x4*)(MIXED + (size_t)row * D + DC + c) = w;
                }
            }
        }
    }
};
struct EpiOut {
    static constexpr bool PERM = true;
    const bf16_t* XB; bf16_t* HB; float* PS;
    __device__ __forceinline__ void operator()(const Acc& acc, const Unit& u, int wr, int wc, int fr, int fq) const {
        const int row0 = u.pm * BM + wr * 64 + fr;
#pragma unroll
        for (int ai = 0; ai < 2; ++ai) {
            u32x4 xv[1][4][2];
#pragma unroll
            for (int m = 0; m < 4; ++m)
#pragma unroll
                for (int bj = 0; bj < 2; ++bj) xv[0][m][bj] = *(const u32x4*)(XB + (size_t)(row0 + ai * HALF + m * 16) * D + u.pn * BM + bj * HALF + wc * 32 + 8 * fq);
#pragma unroll
            for (int m = 0; m < 4; ++m) {
                const int row = row0 + ai * HALF + m * 16; float ss = 0.f;
#pragma unroll
                for (int bj = 0; bj < 2; ++bj) {
                    const size_t off = (size_t)row * D + u.pn * BM + bj * HALF + wc * 32 + 8 * fq;
                    const u32x4 xb = xv[0][m][bj];
                    const f32x4 h0 = (f32x4){bflo(xb.x), bfhi(xb.x), bflo(xb.y), bfhi(xb.y)} + acc[ai][bj][m][0], h1 = (f32x4){bflo(xb.z), bfhi(xb.z), bflo(xb.w), bfhi(xb.w)} + acc[ai][bj][m][1];
                    u32x4 w; w.x = cvt_pk_bf16(h0[0], h0[1]); w.y = cvt_pk_bf16(h0[2], h0[3]); w.z = cvt_pk_bf16(h1[0], h1[1]); w.w = cvt_pk_bf16(h1[2], h1[3]); *(u32x4*)(HB + off) = w;
                    ss += (h0[0] * h0[0] + h0[1] * h0[1]) + (h0[2] * h0[2] + h0[3] * h0[3]) + (h1[0] * h1[0] + h1[1] * h1[1]) + (h1[2] * h1[2] + h1[3] * h1[3]);
                }
                ss += __shfl_xor(ss, 16); ss += __shfl_xor(ss, 32);
                if (fq == 0) PS[(size_t)row * 16 + u.pn * 4 + wc] = ss;
            }
        }
    }
};
struct EpiFF1 {
    static constexpr bool PERM = true;
    const float* PS; bf16_t* HID; const unsigned* p6done; unsigned need;
    __device__ __forceinline__ void operator()(const Acc& acc, const Unit& u, int wr, int wc, int fr, int fq) const {
        const int row0 = u.pm * BM + wr * 64 + fr;
        if (u.pn < 4) { unsigned spins = 0; while ((unsigned)__builtin_amdgcn_readfirstlane(__hip_atomic_load(p6done, __ATOMIC_RELAXED, __HIP_MEMORY_SCOPE_AGENT)) < need) { __builtin_amdgcn_s_sleep(2); if (++spins > (1u << 22)) break; } }
#pragma unroll
        for (int ai = 0; ai < 2; ++ai)
#pragma unroll
            for (int m = 0; m < 4; ++m) {
                const int row = row0 + ai * HALF + m * 16;
#pragma unroll
                for (int bj = 0; bj < 2; ++bj) {
                    const size_t off = (size_t)row * DFF + u.pn * BM + bj * HALF + wc * 32 + 8 * fq;
                    float y[8];
#pragma unroll
                    for (int j = 0; j < 4; ++j) { const float a = fmaxf(acc[ai][bj][m][0][j], 0.f), b = fmaxf(acc[ai][bj][m][1][j], 0.f); y[j] = a * a; y[4 + j] = b * b; }
                    u32x4 w; w.x = cvt_pk_bf16(y[0], y[1]); w.y = cvt_pk_bf16(y[2], y[3]); w.z = cvt_pk_bf16(y[4], y[5]); w.w = cvt_pk_bf16(y[6], y[7]);
                    *(u32x4*)(HID + off) = w;
                }
            }
    }
};
struct EpiFinal {
    static constexpr bool PERM = true;
    float* OUT; const bf16_t* HB; float* PS2; unsigned* cnt; const float* gf; const float* PS; bool local;
    __device__ __forceinline__ void operator()(Acc& acc, const Unit& u, int wr, int wc, int fr, int fq) const {
        const int row0 = u.pm * BM + wr * 64 + fr, col0 = u.pn * BM + wc * 32 + 8 * fq;
#pragma unroll
        for (int ai = 0; ai < 2; ++ai) {
            u32x4 hv[4][2]; f32x4 pv[4];
#pragma unroll
            for (int m = 0; m < 4; ++m) { const int row = row0 + ai * HALF + m * 16; pv[m] = *(const f32x4*)(PS + (size_t)row * 16 + fq * 4);
#pragma unroll
                for (int bj = 0; bj < 2; ++bj) hv[m][bj] = *(const u32x4*)(HB + (size_t)row * D + col0 + bj * HALF); }
#pragma unroll
            for (int m = 0; m < 4; ++m) {
                const int row = row0 + ai * HALF + m * 16; float ss = 0.f;
                const f32x4 pq = pv[m];
                float sq = (pq[0] + pq[1]) + (pq[2] + pq[3]); sq += __shfl_xor(sq, 16); sq += __shfl_xor(sq, 32);
                const float rs2 = __builtin_amdgcn_rcpf(sq * (1.0f / D) + EPS);
#pragma unroll
                for (int bj = 0; bj < 2; ++bj) {
                    const size_t off = (size_t)row * D + col0 + bj * HALF;
                    const u32x4 hb = hv[m][bj];
                    const f32x4 h0 = (f32x4){bflo(hb.x), bfhi(hb.x), bflo(hb.y), bfhi(hb.y)} + acc[ai][bj][m][0] * rs2, h1 = (f32x4){bflo(hb.z), bfhi(hb.z), bflo(hb.w), bfhi(hb.w)} + acc[ai][bj][m][1] * rs2;
                    acc[ai][bj][m][0] = h0; acc[ai][bj][m][1] = h1;
                    ss += (h0[0] * h0[0] + h0[1] * h0[1]) + (h0[2] * h0[2] + h0[3] * h0[3]) + (h1[0] * h1[0] + h1[1] * h1[1]) + (h1[2] * h1[2] + h1[3] * h1[3]);
                }
                ss += __shfl_xor(ss, 16); ss += __shfl_xor(ss, 32);
                if (fq == 0) { if (local) PS2[(size_t)row * 16 + u.pn * 4 + wc] = ss; else __hip_atomic_store((unsigned*)(PS2 + (size_t)row * 16 + u.pn * 4 + wc), __builtin_bit_cast(unsigned, ss), __ATOMIC_RELAXED, __HIP_MEMORY_SCOPE_AGENT); }
            }
        }
        asm volatile("s_waitcnt vmcnt(0)" ::: "memory");
        unsigned* c = cnt + 64 * u.pm;
        if (fr == 0 && fq == 0) __hip_atomic_fetch_add(c, 1u, __ATOMIC_RELAXED, __HIP_MEMORY_SCOPE_AGENT);
        { unsigned spins = 0;
          while ((unsigned)__builtin_amdgcn_readfirstlane(__hip_atomic_load(c, __ATOMIC_RELAXED, __HIP_MEMORY_SCOPE_AGENT)) < 32u) { __builtin_amdgcn_s_sleep(2); if (++spins > (1u << 22)) break; } }
        if (!local) __builtin_amdgcn_fence(__ATOMIC_ACQUIRE, "agent");
        else asm volatile("" ::: "memory");
        f32x4 gg[2][2];
#pragma unroll
        for (int bj = 0; bj < 2; ++bj) { gg[bj][0] = *(const f32x4*)(gf + col0 + bj * HALF); gg[bj][1] = *(const f32x4*)(gf + col0 + bj * HALF + 4); }
#pragma unroll
        for (int ai = 0; ai < 2; ++ai) {
            unsigned qv[4][4];
#pragma unroll
            for (int m = 0; m < 4; ++m) { const unsigned* ps = (const unsigned*)(PS2 + (size_t)(row0 + ai * HALF + m * 16) * 16 + fq * 4);
                if (local) { const u32x4 q4 = *(const u32x4*)ps; qv[m][0] = q4.x; qv[m][1] = q4.y; qv[m][2] = q4.z; qv[m][3] = q4.w; }
                else {
#pragma unroll
                    for (int j = 0; j < 4; ++j) qv[m][j] = __hip_atomic_load(ps + j, __ATOMIC_RELAXED, __HIP_MEMORY_SCOPE_AGENT); } }
#pragma unroll
            for (int m = 0; m < 4; ++m) {
                const int row = row0 + ai * HALF + m * 16;
                float ss = 0.f;
#pragma unroll
                for (int j = 0; j < 4; ++j) ss += __builtin_bit_cast(float, qv[m][j]);
                ss += __shfl_xor(ss, 16); ss += __shfl_xor(ss, 32);
                const float rstd = 1.0f / sqrtf(ss * (1.0f / D) + EPS);
#pragma unroll
                for (int bj = 0; bj < 2; ++bj) {
                    const size_t off = (size_t)row * D + col0 + bj * HALF;
                    *(f32x4*)(OUT + off) = acc[ai][bj][m][0] * rstd * gg[bj][0]; *(f32x4*)(OUT + off + 4) = acc[ai][bj][m][1] * rstd * gg[bj][1];
                }
            }
        }
    }
};
}


#define XB_TMO      128
#define XB_XCNT(j)  (256  + 64 * (j))
#define XB_XSUB(j)  (1280 + 64 * (j))
#define XB_XGEN(j)  (2304 + 64 * (j))
#define XB_TOP      3328
#define XB_TOPGEN   3392
#define XCD_BAR_WORDS 3456
#define XB_SPIN_CAP (1u << 18)
__device__ __forceinline__ unsigned xb_ld(unsigned* p)              { return __hip_atomic_load(p, __ATOMIC_RELAXED, __HIP_MEMORY_SCOPE_AGENT); }
__device__ __forceinline__ unsigned xb_add(unsigned* p, unsigned v) { return __hip_atomic_fetch_add(p, v, __ATOMIC_RELAXED, __HIP_MEMORY_SCOPE_AGENT); }
__device__ __forceinline__ unsigned xb_xcc_id() { return (unsigned)__builtin_amdgcn_s_getreg((3 << 11) | 20) & 0xFu; }
#define XB_SPIN(cond, bar) do { unsigned _sp = 0; while (cond) { __builtin_amdgcn_s_sleep(1); \
    if ((++_sp & 255u) == 0u) { if (xb_ld(&(bar)[XB_TMO])) break; if (_sp > XB_SPIN_CAP) { atomicAdd(&(bar)[XB_TMO], 1u); break; } } } } while (0)
struct XcdBarrier { unsigned* bar; unsigned x; volatile LAS unsigned* st; };
__device__ __forceinline__ XcdBarrier xcd_barrier_post(unsigned* bar, volatile LAS unsigned* st) {
    XcdBarrier b; b.bar = bar; b.x = xb_xcc_id(); b.st = st;
    if (threadIdx.x == 0) st[2] = xb_add(&bar[XB_XCNT(b.x)], 1u);
    return b;
}
#define XL_CNT(j)   (3456 + 64 * (j))
__device__ __forceinline__ void xcc_local_barrier(const XcdBarrier& b, unsigned nloc, bool inval) {
    asm volatile("s_waitcnt vmcnt(0)" ::: "memory");
    __syncthreads();
    if (threadIdx.x == 0) {
        unsigned* bar = b.bar;
        __builtin_amdgcn_s_waitcnt(0);
        const unsigned old = xb_add(&bar[XL_CNT(b.x)], 1u), target = (old / nloc + 1u) * nloc;
        XB_SPIN(xb_ld(&bar[XL_CNT(b.x)]) < target, bar);
        if (inval) { __builtin_amdgcn_fence(__ATOMIC_ACQUIRE, "agent"); asm volatile("s_waitcnt vmcnt(0)" ::: "memory"); }
    }
    __syncthreads();
}
__device__ __forceinline__ void xcd_barrier_complete(unsigned* bar, unsigned x, unsigned& nloc, unsigned& nx) {
    const unsigned G = gridDim.x * gridDim.y * gridDim.z;
    unsigned sum, cnt, mine, sp = 0u;
    for (;;) {
        sum = 0u; cnt = 0u; mine = 0u;
#pragma unroll
        for (unsigned j = 0; j < 16; ++j) { const unsigned c = xb_ld(&bar[XB_XCNT(j)]); sum += c; cnt += (c > 0u) ? 1u : 0u; mine = (j == x) ? c : mine; }
        if (sum == G) break;
        __builtin_amdgcn_s_sleep(1);
        if ((++sp & 255u) == 0u) { if (xb_ld(&bar[XB_TMO])) break; if (sp > XB_SPIN_CAP) { atomicAdd(&bar[XB_TMO], 1u); break; } }
    }
    nloc = mine > 0u ? mine : 1u; nx = cnt > 0u ? cnt : 1u;
}
__device__ __forceinline__ void xcd_barrier(const XcdBarrier& b) {
    asm volatile("s_waitcnt vmcnt(0)" ::: "memory");
    __syncthreads();
    if (threadIdx.x == 0) {
        unsigned* bar = b.bar;
        __builtin_amdgcn_s_waitcnt(0);
        unsigned nloc = b.st[0], nx = b.st[1];
        if (nloc == 0u) { xcd_barrier_complete(bar, b.x, nloc, nx); b.st[0] = nloc; b.st[1] = nx; }
        const unsigned old = xb_add(&bar[XB_XSUB(b.x)], 1u);
        const unsigned gen = old / nloc;
        if (old + 1u == (gen + 1u) * nloc) {
            __builtin_amdgcn_fence(__ATOMIC_RELEASE, "agent");
            asm volatile("s_waitcnt vmcnt(0)" ::: "memory");
            const unsigned og = xb_add(&bar[XB_TOP], 1u);
            const unsigned tg = og / nx;
            if (og + 1u == (tg + 1u) * nx) xb_add(&bar[XB_TOPGEN], 1u);
            else XB_SPIN(xb_ld(&bar[XB_TOPGEN]) == tg, bar);
            __builtin_amdgcn_fence(__ATOMIC_ACQUIRE, "agent");
            xb_add(&bar[XB_XGEN(b.x)], 1u);
            asm volatile("s_waitcnt vmcnt(0)" ::: "memory");
        } else {
            XB_SPIN(xb_ld(&bar[XB_XGEN(b.x)]) == gen, bar);
            __builtin_amdgcn_fence(__ATOMIC_ACQUIRE, "agent");
            asm volatile("s_waitcnt vmcnt(0)" ::: "memory");
        }
    }
    __syncthreads();
}

struct Args { const float* in[23]; float* out; unsigned char* ws; int ph_lo, ph_hi; };
enum { I_X = 0, I_META, I_G1, I_WIN, I_CW, I_CB, I_LNG, I_LNB, I_LRE, I_LIM, I_LDT, I_BRE, I_BIM, I_CRE, I_CIM, I_DSK, I_GLUW, I_GLUB, I_WOUT, I_G2, I_W1, I_W2, I_GF };

__device__ __forceinline__ void transpose_item(const float* W, int K, int N, bf16_t* WT, int k0, int srcn0, int dstn0, const float* kscale, LAS float* scr, int lane) {
    f32x4 v[8];
#pragma unroll
    for (int i = 0; i < 8; ++i) { const int kk = 8 * i + (lane >> 3); v[i] = *(const f32x4*)(W + (size_t)(k0 + kk) * N + srcn0 + 4 * (lane & 7)); }
    if (kscale) {
#pragma unroll
        for (int i = 0; i < 8; ++i) v[i] = v[i] * kscale[k0 + 8 * i + (lane >> 3)];
    }
#pragma unroll
    for (int i = 0; i < 8; ++i) { LAS float* d = scr + (8 * i + (lane >> 3)) * 33 + 4 * (lane & 7); d[0] = v[i][0]; d[1] = v[i][1]; d[2] = v[i][2]; d[3] = v[i][3]; }
    asm volatile("s_waitcnt lgkmcnt(0)" ::: "memory");
    const int c = lane & 7;
#pragma unroll
    for (int j = 0; j < 4; ++j) { const int n = (lane >> 3) + 8 * j; const LAS float* s = scr + (8 * c) * 33 + n;
        u32x4 o; o.x = pk2(s[0 * 33], s[1 * 33]); o.y = pk2(s[2 * 33], s[3 * 33]); o.z = pk2(s[4 * 33], s[5 * 33]); o.w = pk2(s[6 * 33], s[7 * 33]);
        *(u32x4*)(WT + (size_t)(dstn0 + n) * K + k0 + 8 * c) = o; }
    asm volatile("s_waitcnt lgkmcnt(0)" ::: "memory");
}

__device__ __forceinline__ void phase_transposes(const Args& a, LAS unsigned char* lds, int lane, int wave, int gw, int NGW, int it0, int it1) {
    unsigned char* ws = a.ws;
    LAS float* scr = (LAS float*)(lds + wave * 16384);
    constexpr int I_IN = 16 * 48, I_GL = 8 * 16, I_OU = 16 * 32, I_1 = 16 * 128;
    for (int it = it0 + gw; it < it1; it += NGW) {
        int r = it;
        if (r < I_IN) { const int kb = r / 48, nb = r % 48, n0 = nb * 32; int src;
            if (n0 < 1024) { const int pn = n0 >> 8, rr = n0 & 255; src = rr < 128 ? pn * 128 + rr : 512 + pn * 128 + (rr - 128); } else src = n0;
            transpose_item(a.in[I_WIN], 1024, 1536, (bf16_t*)(ws + WS_WINT), kb * 64, src, n0, a.in[I_G1], scr, lane); continue; } r -= I_IN;
        if (r < I_GL) { const int kb = r / 16, nb = r % 16; transpose_item(a.in[I_GLUW], 512, 512, (bf16_t*)(ws + WS_GLUT), kb * 64, nb * 32, nb * 32, nullptr, scr, lane); continue; } r -= I_GL;
        if (r < I_OU) { const int kb = r / 32, nb = r % 32; transpose_item(a.in[I_WOUT], 1024, 1024, (bf16_t*)(ws + WS_WOUTT), kb * 64, nb * 32, nb * 32, nullptr, scr, lane); continue; } r -= I_OU;
        if (r < I_1) { const int kb = r / 128, nb = r % 128; transpose_item(a.in[I_W1], 1024, 4096, (bf16_t*)(ws + WS_W1T), kb * 64, nb * 32, nb * 32, a.in[I_G2], scr, lane); continue; } r -= I_1;
        { const int kb = r / 32, nb = r % 32; transpose_item(a.in[I_W2], 4096, 1024, (bf16_t*)(ws + WS_W2T), kb * 64, nb * 32, nb * 32, nullptr, scr, lane); }
    }
}

__device__ __forceinline__ void xb_rows(const Args& a, int lane, int m_begin, int m_end, int gwz, int NGWz) {
    unsigned char* ws = a.ws;
    bf16_t* Z1 = (bf16_t*)(ws + WS_Z1); float* RS1 = (float*)(ws + WS_SMALL + SM_RS1);
    for (int m0 = m_begin + gwz * 4; m0 < m_end; m0 += NGWz * 4) {
        if (m0 >= NTOK + 16) {
#pragma unroll
            for (int r = 0; r < 4; ++r) { u32x2* o8 = (u32x2*)(Z1 + (size_t)(m0 + r) * D) + lane;
#pragma unroll
                for (int j = 0; j < 4; ++j) o8[64 * j] = (u32x2){0u, 0u};
                if (lane == 0) RS1[m0 + r] = 0.f; }
            continue; }
        f32x4 v[4][4];
#pragma unroll
        for (int r = 0; r < 4; ++r) { const int m = m0 + r;
            const f32x4* xr = (const f32x4*)(m < NTOK ? a.in[I_X] + (size_t)m * D : a.in[I_META] + (size_t)(m - NTOK) * D) + lane;
#pragma unroll
            for (int j = 0; j < 4; ++j) v[r][j] = xr[64 * j]; }
#pragma unroll
        for (int r = 0; r < 4; ++r) { const int m = m0 + r; u32x2* o8 = (u32x2*)(Z1 + (size_t)m * D) + lane; float s = 0.f;
#pragma unroll
            for (int j = 0; j < 4; ++j) { s += (v[r][j][0] * v[r][j][0] + v[r][j][1] * v[r][j][1]) + (v[r][j][2] * v[r][j][2] + v[r][j][3] * v[r][j][3]); o8[64 * j] = (u32x2){pk2(v[r][j][0], v[r][j][1]), pk2(v[r][j][2], v[r][j][3])}; }
            const float rstd = 1.0f / sqrtf(wave_sum(s) * (1.0f / D) + EPS);
            if (lane == 0) RS1[m] = rstd; }
    }
}

__device__ __forceinline__ void phase0(const Args& a, LAS unsigned char* lds, int tid, int lane, int wave) {
    unsigned char* ws = a.ws;
    const bool split = gridDim.x >= 256;
    const int gw = split ? ((int)blockIdx.x - 128) * 8 + wave : (int)blockIdx.x * 8 + wave, NGW = split ? ((int)gridDim.x - 128) * 8 : (int)gridDim.x * 8;
#ifndef P0_PARTS
#define P0_PARTS 7
#endif
    for (int item = blockIdx.x; item < ((P0_PARTS & 1) ? 128 : 0); item += gridDim.x) {
        const int g = item >> 2, dir = (item >> 1) & 1, hh = item & 1;
        LAS f32x2* pw = (LAS f32x2*)lds;
        LAS f32x2* Bb = pw + 33 * 64;
        LAS f32x2* Cc = Bb + 64 * 16;
        LAS f32x2* cf = Cc + 16 * 64;
        const float* lre = a.in[I_LRE] + (dir * NG + g) * 64; const float* lim = a.in[I_LIM] + (dir * NG + g) * 64;
        const double dt = exp((double)a.in[I_LDT][dir * NG + g]);
        if (tid < 64) {
            const double lr = lre[tid], li = lim[tid], mg = exp(lr * dt); double sn, cs; sincos_d(li * dt, sn, cs);
            const double br = mg * cs - 1.0, bi = mg * sn, den = lr * lr + li * li;
            cf[tid] = (f32x2){(float)((br * lr + bi * li) / den), (float)((bi * lr - br * li) / den)};
        }
#pragma unroll 1
        for (int idx = tid; idx < 33 * 64; idx += 512) { const int j = idx >> 6, p = idx & 63; const double lr = lre[p], li = lim[p], an = j * li * dt;
            const float mg = expf((float)(j * lr * dt));
            const double k = rint(an * 0.15915494309189535); double r = fma(-k, 6.283185307179586, an); r = fma(-k, 2.4492935982947064e-16, r);
            const float rf = (float)r;
            pw[idx] = (f32x2){mg * cosf(rf), mg * sinf(rf)}; }
        __syncthreads();
        for (int idx = tid; idx < 1024; idx += 512) {
            const int p = idx >> 4; const f32x2 c = cf[p]; const size_t gi = (size_t)(dir * NG + g) * 1024 + idx;
            const float br = a.in[I_BRE][gi], bi = a.in[I_BIM][gi];
            Bb[idx] = (f32x2){c.x * br - c.y * bi, c.x * bi + c.y * br};
            Cc[idx] = (f32x2){a.in[I_CRE][gi], a.in[I_CIM][gi]};
        }
        __syncthreads();
        { float* KT = (float*)(ws + WS_KT); const int e = tid & 255, ho = e >> 4, hi = e & 15, d0 = hh * 16 + (tid >> 8) * 8;
          f32x2 q[64];
#pragma unroll
          for (int p = 0; p < 64; ++p) { const f32x2 c = Cc[ho * 64 + p], b = Bb[p * 16 + hi]; q[p] = (f32x2){c.x * b.x - c.y * b.y, c.x * b.y + c.y * b.x}; }
#pragma unroll 1
          for (int d = d0; d < d0 + 8; ++d) { float s0 = 0.f, s1 = 0.f;
#pragma unroll
              for (int p = 0; p < 64; p += 2) { const f32x4 w = *(const LAS f32x4*)(pw + d * 64 + p); s0 += q[p].x * w[0] - q[p].y * w[1]; s1 += q[p + 1].x * w[2] - q[p + 1].y * w[3]; }
              KT[((size_t)(g * 2 + dir) * 32 + d) * 256 + e] = s0 + s1; } }
        { bf16_t* WST = (bf16_t*)(ws + WS_WST);
#pragma unroll 1
          for (int idx = hh * 64 * 256 + tid; idx < (hh + 1) * 64 * 256; idx += 512) { const int nn = idx >> 8, kp = idx & 255, p = nn >> 1, c = nn & 1, k = 2 * kp, s = k >> 4, hi = k & 15, e = dir == 0 ? 31 - s : s;
              const f32x2 w = pw[e * 64 + p], b0 = Bb[p * 16 + hi], b1 = Bb[p * 16 + hi + 1];
              const float v0 = c ? (w.x * b0.y + w.y * b0.x) : (w.x * b0.x - w.y * b0.y), v1 = c ? (w.x * b1.y + w.y * b1.x) : (w.x * b1.x - w.y * b1.y);
              *(unsigned*)(WST + ((size_t)g * 256 + dir * 128 + nn) * 512 + k) = pk2(v0, v1); } }
        { bf16_t* BTS = (bf16_t*)(ws + WS_BTS);
#pragma unroll 1
          for (int idx = hh * 256 * 64 + tid; idx < (hh + 1) * 256 * 64; idx += 512) { const int n = idx >> 6, p = idx & 63, t = n >> 4, ho = n & 15, e = dir == 0 ? t + 1 : 32 - t;
              const f32x2 c = Cc[ho * 64 + p], w = pw[e * 64 + p];
              *(unsigned*)(BTS + ((size_t)g * 512 + n) * KS + 512 + dir * 128 + 2 * p) = pk2(c.x * w.x - c.y * w.y, -(c.x * w.y + c.y * w.x)); } }
        if (hh == 0 && tid < 64) { ((f32x2*)(ws + WS_SMALL + SM_LAMT))[(g * 2 + dir) * 64 + tid] = pw[32 * 64 + tid];
            if (dir == 0) ((f32x2*)(ws + WS_SMALL + SM_LBF))[g * 64 + tid] = pw[64 + tid]; }
        if (hh == 0 && dir == 0) for (int idx = tid; idx < 1024; idx += 512) ((f32x2*)(ws + WS_SMALL + SM_BBF))[(size_t)g * 1024 + idx] = Bb[idx];
        __syncthreads();
    }
    if ((P0_PARTS & 2) && gw >= 0) phase_transposes(a, lds, lane, wave, gw, NGW, 0, 768);
    if ((P0_PARTS & 4) && gw >= 0) xb_rows(a, lane, 0, split ? NTOK : MROWS, gw, NGW);
    if ((P0_PARTS & 4) && split && (int)blockIdx.x < 128) xb_rows(a, lane, NTOK, MROWS, (int)blockIdx.x * 8 + wave, 128 * 8);
}

__device__ __forceinline__ void phase_conv(const Args& a, LAS unsigned char* lds, int tid, int lane, int wave, int it0, int it1, int stride) {
    const bf16_t* UC = (const bf16_t*)(a.ws + WS_UC); bf16_t* MIXED = (bf16_t*)(a.ws + WS_MIXED);
    LAS unsigned char* ut = lds;
    LAS float* yt = (LAS float*)(lds + 49152);
    const int cp = tid & 255, half = tid >> 8;
    const float* cw = a.in[I_CW];
    f32x2 wk[31];
#pragma unroll
    for (int k = 0; k < 31; ++k) wk[k] = *(const f32x2*)(cw + k * DC + 2 * cp);
    const f32x2 bia = *(const f32x2*)(a.in[I_CB] + 2 * cp);
    const f32x4 lg0 = *(const f32x4*)(a.in[I_LNG] + lane * 8), lg1 = *(const f32x4*)(a.in[I_LNG] + lane * 8 + 4), lb0 = *(const f32x4*)(a.in[I_LNB] + lane * 8), lb1 = *(const f32x4*)(a.in[I_LNB] + lane * 8 + 4);
    u32x4 pf[6];
#define CONV_FETCH(item) do { const int b_ = (item) >> 8, q0_ = ((item) & 255) * 16; _Pragma("unroll") for (int e_ = 0; e_ < 6; ++e_) { const int idx = tid + e_ * 512, r = idx >> 6, cc = idx & 63, q = q0_ - 15 + r; \
        u32x4 v = (u32x4){0u, 0u, 0u, 0u}; \
        if (idx < 46 * 64) { if (q >= 0 && q < SEQ) v = *(const u32x4*)(UC + ((size_t)b_ * SEQ + q) * DC + cc * 8); else if (q < 0) v = *(const u32x4*)(UC + ((size_t)NTOK + 16 + q) * DC + cc * 8); } \
        pf[e_] = v; } } while (0)
    if (it0 < it1) CONV_FETCH(it0);
    for (int it = it0; it < it1; it += stride) {
        const int b = it >> 8, q0 = (it & 255) * 16;
#pragma unroll
        for (int e_ = 0; e_ < 6; ++e_) { const int idx = tid + e_ * 512, r = idx >> 6, cc = idx & 63; if (idx < 46 * 64) *(LAS u32x4*)(ut + r * 1024 + cc * 16) = pf[e_]; }
        __syncthreads();
        if (it + stride < it1) CONV_FETCH(it + stride);
        {
            f32x2 ac[8];
#pragma unroll
            for (int j = 0; j < 8; ++j) ac[j] = bia;
#pragma unroll
            for (int i = 0; i < 38; ++i) {
                const unsigned w = *(const LAS unsigned*)(ut + (half * 8 + i) * 1024 + cp * 4); const f32x2 uu = (f32x2){bflo(w), bfhi(w)};
#pragma unroll
                for (int j = 0; j < 8; ++j) { const int k = i - j; if (k >= 0 && k < 31) ac[j] = __builtin_elementwise_fma(wk[k], uu, ac[j]); }
            }
#pragma unroll
            for (int j = 0; j < 8; ++j) *(LAS f32x2*)(yt + (half * 8 + j) * 512 + 2 * cp) = ac[j];
        }
        __syncthreads();
        {
            const int t0 = wave * 2;
            f32x4 v[2][2]; float s1[2], s2[2];
#pragma unroll
            for (int tt = 0; tt < 2; ++tt) { v[tt][0] = *(const LAS f32x4*)(yt + (t0 + tt) * 512 + lane * 8); v[tt][1] = *(const LAS f32x4*)(yt + (t0 + tt) * 512 + lane * 8 + 4);
                const f32x4 a0 = v[tt][0], a1 = v[tt][1];
                s1[tt] = (a0[0] + a0[1]) + (a0[2] + a0[3]) + (a1[0] + a1[1]) + (a1[2] + a1[3]);
                s2[tt] = (a0[0] * a0[0] + a0[1] * a0[1]) + (a0[2] * a0[2] + a0[3] * a0[3]) + (a1[0] * a1[0] + a1[1] * a1[1]) + (a1[2] * a1[2] + a1[3] * a1[3]); }
#pragma unroll
            for (int o = 1; o < 64; o <<= 1) { const float p0 = __shfl_xor(s1[0], o), p1 = __shfl_xor(s2[0], o), p2 = __shfl_xor(s1[1], o), p3 = __shfl_xor(s2[1], o); s1[0] += p0; s2[0] += p1; s1[1] += p2; s2[1] += p3; }
#pragma unroll
            for (int tt = 0; tt < 2; ++tt) {
                const float mean = s1[tt] * (1.0f / DC), var = fmaxf(s2[tt] * (1.0f / DC) - mean * mean, 0.f), rstd = 1.0f / sqrtf(var + EPS);
                f32x4 y0 = (v[tt][0] - mean) * rstd * lg0 + lb0, y1 = (v[tt][1] - mean) * rstd * lg1 + lb1;
#pragma unroll
                for (int j = 0; j < 4; ++j) { y0[j] = y0[j] * sigmoidf_(y0[j]); y1[j] = y1[j] * sigmoidf_(y1[j]); }
                u32x4 w; w.x = cvt_pk_bf16(y0[0], y0[1]); w.y = cvt_pk_bf16(y0[2], y0[3]); w.z = cvt_pk_bf16(y1[0], y1[1]); w.w = cvt_pk_bf16(y1[2], y1[3]);
                *(u32x4*)(MIXED + ((size_t)b * SEQ + q0 + t0 + tt) * D + lane * 8) = w;
            }
        }
        __syncthreads();
    }
}

__device__ __forceinline__ void phase_toeplitz(const Args& a, int tid, int sidx, int scnt) {
    const float* KT = (const float*)(a.ws + WS_KT); bf16_t* BTS = (bf16_t*)(a.ws + WS_BTS);
    const size_t total = (size_t)NG * 512 * 64;
    for (size_t idx = (size_t)sidx * 512 + tid; idx < total; idx += (size_t)scnt * 512) {
        const int kc = (int)(idx & 63), n = (int)((idx >> 6) & 511), g = (int)(idx >> 15);
        const int t = n >> 4, ho = n & 15, k = kc * 8, s = k >> 4, hi = k & 15, d = t - s;
        f32x4 v0, v1;
        if (d > 0) { const float* p = KT + ((size_t)(g * 2 + 0) * 32 + d) * 256 + ho * 16 + hi; v0 = *(const f32x4*)p; v1 = *(const f32x4*)(p + 4); }
        else if (d < 0) { const float* p = KT + ((size_t)(g * 2 + 1) * 32 - d) * 256 + ho * 16 + hi; v0 = *(const f32x4*)p; v1 = *(const f32x4*)(p + 4); }
        else { const float* p = KT + ((size_t)(g * 2 + 0) * 32) * 256 + ho * 16 + hi; const float* q = KT + ((size_t)(g * 2 + 1) * 32) * 256 + ho * 16 + hi;
            v0 = *(const f32x4*)p + *(const f32x4*)q; v1 = *(const f32x4*)(p + 4) + *(const f32x4*)(q + 4); }
        u32x4 w; w.x = pk2(v0[0], v0[1]); w.y = pk2(v0[2], v0[3]); w.z = pk2(v1[0], v1[1]); w.w = pk2(v1[2], v1[3]);
        *(u32x4*)(BTS + ((size_t)g * 512 + n) * KS + k) = w;
    }
}

template <int DIR>
__device__ __forceinline__ void scan_run(const f32x2* __restrict__ sl, unsigned* __restrict__ dst, const f32x2 lt, float xr, float xi) {
    constexpr int BT = 8, NB = NCH / BT;
    f32x2 s0[BT], s1[BT], s2[BT];
#define SCAN_LD(dstv, bt) do { _Pragma("unroll") for (int j = 0; j < BT; ++j) { const int cc = (bt) * BT + j, c = DIR == 0 ? cc : NCH - 1 - cc; dstv[j] = sl[(size_t)c * 128]; } } while (0)
#define SCAN_RUN(srcv, bt) do { _Pragma("unroll") for (int j = 0; j < BT; ++j) { const int cc = (bt) * BT + j, c = DIR == 0 ? cc : NCH - 1 - cc; \
        dst[(size_t)c * (KS / 2)] = pk2(xr, xi); const float nr = lt[0] * xr - lt[1] * xi + srcv[j][0], ni = lt[0] * xi + lt[1] * xr + srcv[j][1]; xr = nr; xi = ni; } } while (0)
    SCAN_LD(s0, 0); SCAN_LD(s1, 1);
#pragma unroll 1
    for (int bt = 0; bt < NB; bt += 3) {
        if (bt + 2 < NB) SCAN_LD(s2, bt + 2);
        SCAN_RUN(s0, bt);
        if (bt + 1 < NB) { if (bt + 3 < NB) SCAN_LD(s0, bt + 3); SCAN_RUN(s1, bt + 1); }
        if (bt + 2 < NB) { if (bt + 4 < NB) SCAN_LD(s1, bt + 4); SCAN_RUN(s2, bt + 2); }
    }
#undef SCAN_LD
#undef SCAN_RUN
}
__device__ __forceinline__ void scan_one(const Args& a, int b, int g, int dir, int p) {
    unsigned char* ws = a.ws;
    const float* SL = (const float*)(ws + WS_SL); bf16_t* AS = (bf16_t*)(ws + WS_AS);
    const f32x2 lt = ((const f32x2*)(ws + WS_SMALL + SM_LAMT))[(g * 2 + dir) * 64 + p];
    const f32x2* sl = (const f32x2*)(SL + ((size_t)g * 512 + b * NCH) * 256 + dir * 128 + 2 * p);
    unsigned* dst = (unsigned*)(AS + ((size_t)g * 512 + b * NCH) * KS + 512 + dir * 128 + 2 * p);
    if (dir == 0) {
        float xr = 0.f, xi = 0.f;
        const f32x2 lb = ((const f32x2*)(ws + WS_SMALL + SM_LBF))[g * 64 + p];
        const f32x2* bb = (const f32x2*)(ws + WS_SMALL + SM_BBF) + (size_t)(g * 64 + p) * 16;
        const bf16_t* um = (const bf16_t*)(ws + WS_SMALL + SM_UMETA) + g * 16;
        f32x2 bv[16];
#pragma unroll
        for (int h = 0; h < 16; ++h) bv[h] = bb[h];
#pragma unroll 4
        for (int s = 0; s < 16; ++s) { float br = 0.f, bi = 0.f;
            const u32x4 u0 = *(const u32x4*)(um + s * DS), u1 = *(const u32x4*)(um + s * DS + 8);
            const float uv[16] = {bflo(u0.x), bfhi(u0.x), bflo(u0.y), bfhi(u0.y), bflo(u0.z), bfhi(u0.z), bflo(u0.w), bfhi(u0.w), bflo(u1.x), bfhi(u1.x), bflo(u1.y), bfhi(u1.y), bflo(u1.z), bfhi(u1.z), bflo(u1.w), bfhi(u1.w)};
#pragma unroll
            for (int h = 0; h < 16; ++h) { br += bv[h][0] * uv[h]; bi += bv[h][1] * uv[h]; }
            const float nr = lb[0] * xr - lb[1] * xi + br, ni = lb[0] * xi + lb[1] * xr + bi; xr = nr; xi = ni; }
        scan_run<0>(sl, dst, lt, xr, xi);
    } else scan_run<1>(sl, dst, lt, 0.f, 0.f);
}

__device__ __forceinline__ void phase_final(const Args& a, int lane, int wave) {
    const float* PS2 = (const float*)(a.ws + WS_PS2);
    f32x4 gv[4];
#pragma unroll
    for (int j = 0; j < 4; ++j) gv[j] = ((const f32x4*)a.in[I_GF])[lane + 64 * j];
    for (int m = blockIdx.x * 8 + wave; m < NTOK; m += gridDim.x * 8) {
        float ss = PS2[(size_t)m * 16 + (lane & 15)];
        ss += __shfl_xor(ss, 1); ss += __shfl_xor(ss, 2); ss += __shfl_xor(ss, 4); ss += __shfl_xor(ss, 8);
        const float rstd = 1.0f / sqrtf(ss * (1.0f / D) + EPS);
        f32x4* row = (f32x4*)(a.out + (size_t)m * D) + lane;
#pragma unroll
        for (int j = 0; j < 4; ++j) { const f32x4 v = row[64 * j]; row[64 * j] = v * rstd * gv[j]; }
    }
}

constexpr int NPHASE = 10;
template <bool COOP>
__global__ void __launch_bounds__(512, 2) fwd_kernel(Args a) {
    extern __shared__ __attribute__((aligned(16))) unsigned char lds_raw[];
    LAS unsigned char* lds = (LAS unsigned char*)lds_raw;
    const int tid = threadIdx.x, lane = tid & 63, wave = __builtin_amdgcn_readfirstlane(tid >> 6);
    unsigned char* ws = a.ws;
    const int lo = a.ph_lo, hi = a.ph_hi, G = gridDim.x; int bid = blockIdx.x; bool xloc = false;
    volatile LAS unsigned* MISC = (volatile LAS unsigned*)(lds + 131072 + 320);
    if (tid < 64) MISC[tid] = 0u;
    __syncthreads();
    XcdBarrier bar; bar.bar = (unsigned*)ws; bar.x = 0; bar.st = MISC + 8;
    if (COOP) bar = xcd_barrier_post((unsigned*)ws, MISC + 8);
#ifndef PHASE_MASK
#define PHASE_MASK 0x3ff
#endif
#define IN(k) (((PHASE_MASK >> (k)) & 1) && lo <= (k) && (k) < hi)
#define NEXTP(k) ((k) == 2 ? 5 : (k) + 1)
#ifndef REP_MASK
#define REP_MASK 0
#endif
#define RP(k) (((REP_MASK >> (k)) & 1) ? 3 : 1)
#ifndef EXTRA_SYNCS
#define EXTRA_SYNCS 0
#endif
#define REPS(k) for (int rep_ = 0; rep_ < (((REP_MASK >> (k)) & 1) ? 3 : 1); ++rep_)
#define SYNC(k) do { if (COOP && IN(k) && IN(NEXTP(k))) { xcd_barrier(bar); } } while (0)
    if (IN(0)) { phase0(a, lds, tid, lane, wave); __syncthreads(); }
    SYNC(0);
    if (COOP && lo == 0 && G == 256) {
        if (tid == 0) { unsigned ok = 1u; for (unsigned j = 0; j < 16; ++j) { const unsigned c = xb_ld(&bar.bar[XB_XCNT(j)]); if (c != (j < 8 ? 32u : 0u)) ok = 0u; } MISC[11] = ok; }
        __syncthreads();
        if (MISC[11] != 0u && bar.x < 8u && MISC[10] < 32u) { xloc = true; bid = (int)(MISC[10] * 8u + bar.x); }
    }
    if (IN(1)) {
        pg8::Gemm g{(const bf16_t*)(ws + WS_Z1), (const bf16_t*)(ws + WS_WINT), D, D, D, 0, 0};
        pg8::Order S; S.init(MROWS / 256, 1536 / 256, 1, G, bid, RP(1));
        pg8::EpiIn E{(bf16_t*)(ws + WS_UC), (bf16_t*)(ws + WS_AS), (bf16_t*)(ws + WS_SMALL + SM_UMETA), (const float*)(ws + WS_SMALL + SM_RS1)};
        pg8::gemm_phase<pg8::EpiIn>(lds, g, S, E);
        const int n2 = S.nwg - (S.nwg / G) * G;
        if (n2 == 0 || bid >= n2) { const int sidx = n2 == 0 ? bid : bid - n2, scnt = n2 == 0 ? G : G - n2;
            phase_toeplitz(a, tid, sidx, scnt);
            phase_transposes(a, lds, lane, wave, sidx * 8 + wave, scnt * 8, 768, 5504); }
    }
    SYNC(1);
    if (IN(2)) {
        unsigned* flags = (unsigned*)(ws + 49152);
        if (bid < 128) {
            const int xcd = bid & 7, j = bid >> 3, gg = xcd * 4 + (j >> 2), pm = (j >> 1) & 1, pn = j & 1;
            __syncthreads();
            if (bid < 64) phase_conv(a, lds, tid, lane, wave, bid, 192, 64); else phase_conv(a, lds, tid, lane, wave, 192 + (bid - 64), 320, 64);
            __syncthreads();
            pg8::Gemm g{(const bf16_t*)(ws + WS_AS), (const bf16_t*)(ws + WS_BTS), KS, KS, KS, (size_t)512 * KS, (size_t)512 * KS};
            pg8::OneUnit S{{pm, pn, gg}, flags + 64 * (gg * 2 + pm), 6, xloc}; pg8::EpiSsm E{(const bf16_t*)(ws + WS_AS), a.in[I_DSK], (bf16_t*)(ws + WS_YG)};
            pg8::gemm_phase<pg8::EpiSsm, pg8::OneUnit>(lds, g, S, E);
        } else if (bid < 192) {
            const int xcd = bid & 7, j = (bid - 128) >> 3, gg = xcd * 4 + (j >> 1), pm = j & 1;
            __syncthreads();
            { pg8::Gemm g{(const bf16_t*)(ws + WS_AS), (const bf16_t*)(ws + WS_WST), KS, 512, 512, (size_t)512 * KS, (size_t)256 * 512};
              pg8::OneUnit S{{pm, 0, gg}, nullptr, -1, false}; pg8::EpiSL E{(float*)(ws + WS_SL)};
              pg8::gemm_phase<pg8::EpiSL, pg8::OneUnit>(lds, g, S, E); }
            asm volatile("s_waitcnt vmcnt(0)" ::: "memory"); __syncthreads();
            if (tid < 256) scan_one(a, 2 * pm + (tid >> 7), gg, (tid >> 6) & 1, tid & 63);
            asm volatile("s_waitcnt vmcnt(0)" ::: "memory"); __syncthreads();
            if (tid == 0) { if (!xloc) { __builtin_amdgcn_fence(__ATOMIC_RELEASE, "agent"); asm volatile("s_waitcnt vmcnt(0)" ::: "memory"); }
                __hip_atomic_store(flags + 64 * (gg * 2 + pm), 1u, __ATOMIC_RELAXED, __HIP_MEMORY_SCOPE_AGENT); }
            phase_conv(a, lds, tid, lane, wave, 320 + (bid - 128), 512, 64);
        } else {
            __syncthreads();
            phase_conv(a, lds, tid, lane, wave, 512 + (bid - 192), 1024, 64);
        }
    }
    SYNC(2);
    if (IN(5)) {
        __syncthreads();
        pg8::Gemm g{(const bf16_t*)(ws + WS_YG), (const bf16_t*)(ws + WS_GLUT), DS, DS, DS, 0, 0};
        pg8::Order S; S.init(NTOK / 256, 2, 1, G, bid, RP(5));
        pg8::EpiGlu E{(const bf16_t*)(ws + WS_YG), a.in[I_GLUB], (bf16_t*)(ws + WS_MIXED)};
        pg8::gemm_phase<pg8::EpiGlu>(lds, g, S, E);
    }
    if (xloc) xcc_local_barrier(bar, 32u, false); else SYNC(5);
    if (IN(6)) {
        __syncthreads();
        pg8::Gemm g{(const bf16_t*)(ws + WS_MIXED), (const bf16_t*)(ws + WS_WOUTT), D, D, D, 0, 0};
        pg8::Order S; S.init(NTOK / 256, 4, 1, G, bid, RP(6));
        pg8::EpiOut E{(const bf16_t*)(ws + WS_Z1), (bf16_t*)(ws + WS_H2B), (float*)(ws + WS_PS)};
        pg8::gemm_phase<pg8::EpiOut>(lds, g, S, E);
        if (tid == 0) __hip_atomic_fetch_add((unsigned*)(ws + 65536), 1u, __ATOMIC_RELAXED, __HIP_MEMORY_SCOPE_AGENT);
    }
    if (xloc) xcc_local_barrier(bar, 32u, false); else SYNC(6);
    if (IN(7)) {
        pg8::Gemm g{(const bf16_t*)(ws + WS_H2B), (const bf16_t*)(ws + WS_W1T), D, D, D, 0, 0};
        pg8::Order S; S.init(NTOK / 256, DFF / 256, 1, G, bid, RP(7));
        pg8::EpiFF1 E{(const float*)(ws + WS_PS), (bf16_t*)(ws + WS_HID), (const unsigned*)(ws + 65536), (unsigned)G};
        pg8::gemm_phase<pg8::EpiFF1>(lds, g, S, E);
    }
    if (xloc) xcc_local_barrier(bar, 32u, true); else SYNC(7);
    if (IN(8)) {
        pg8::Gemm g{(const bf16_t*)(ws + WS_HID), (const bf16_t*)(ws + WS_W2T), DFF, DFF, DFF, 0, 0};
        pg8::Order S; S.init(NTOK / 256, 4, 1, G, bid);
        pg8::EpiFinal E{a.out, (const bf16_t*)(ws + WS_H2B), (float*)(ws + WS_PS2), (unsigned*)(ws + 32768), a.in[I_GF], (const float*)(ws + WS_PS), xloc};
        pg8::gemm_phase<pg8::EpiFinal>(lds, g, S, E);
    }

#undef IN
#undef SYNC
}

extern "C" void kernel_launch(void* const* d_in, const int* in_sizes, int n_in, void* d_out, int out_size, void* d_ws, size_t ws_size, hipStream_t stream) {
    static int grid = 0;
    if (grid == 0) {
        if (n_in != 23 || out_size != NTOK * D || ws_size < WS_END) { fprintf(stderr, "kernel_launch: unexpected problem (n_in %d out %d ws %zu)\n", n_in, out_size, ws_size); grid = -1; return; }
        int dev = 0, cus = 0, per_cu = 0;
        hipGetDevice(&dev); hipDeviceGetAttribute(&cus, hipDeviceAttributeMultiprocessorCount, dev);
        hipFuncSetAttribute((const void*)fwd_kernel<true>, hipFuncAttributeMaxDynamicSharedMemorySize, LDS_BYTES);
        hipFuncSetAttribute((const void*)fwd_kernel<false>, hipFuncAttributeMaxDynamicSharedMemorySize, LDS_BYTES);
        hipOccupancyMaxActiveBlocksPerMultiprocessor(&per_cu, (const void*)fwd_kernel<true>, 512, LDS_BYTES);
        if (per_cu < 1) { fprintf(stderr, "kernel_launch: the occupancy query reports %d workgroups per CU for this kernel + %d B of LDS: a resident grid is impossible, nothing launched\n", per_cu, LDS_BYTES); grid = -1; return; }
        (void)hipGetLastError();
        grid = cus;
        if (grid < 256) { fprintf(stderr, "kernel_launch: this kernel's phase program needs >= 256 CUs (got %d)\n", cus); grid = -1; return; }
    }
    if (grid < 0) return;
    Args a{};
    for (int i = 0; i < 23; ++i) a.in[i] = (const float*)d_in[i];
    a.out = (float*)d_out; a.ws = (unsigned char*)d_ws;
#if MK_MULTI
    for (int p = 0; p < NPHASE; ++p) { a.ph_lo = p; a.ph_hi = p + 1; hipLaunchKernelGGL(fwd_kernel<false>, dim3(grid), dim3(512), LDS_BYTES, stream, a); }
#else
    a.ph_lo = 0; a.ph_hi = NPHASE;
    if (hipMemsetAsync(d_ws, 0, 131072, stream) != hipSuccess) { fprintf(stderr, "kernel_launch: memset of barrier words failed\n"); return; }
    void* args[] = {&a};
    hipError_t e = hipLaunchCooperativeKernel((const void*)fwd_kernel<true>, dim3(grid), dim3(512), args, LDS_BYTES, stream);
    if (e != hipSuccess) fprintf(stderr, "cooperative launch failed: %s (grid %d)\n", hipGetErrorString(e), grid);
#endif
}
```
